# Optimizing an MI355X kernel written in HIP

```python
import math
import jax, jax.numpy as jnp
from jax import lax
import numpy as np

D_MODEL = 1024
BATCH = 8
SEQ = 4096
DEPTH = 1

MIX_WIDTH = D_MODEL
N_MLSTM_HEADS = 4
MLSTM_HEAD_DIM = 128
MLSTM_WIDTH = N_MLSTM_HEADS * MLSTM_HEAD_DIM
N_SB_HEADS = 8
SB_HEAD_DIM = 64
SB_WIDTH = N_SB_HEADS * SB_HEAD_DIM
CONV_WIDTH = 4
MLSTM_CHUNK = 128
SB_BLOCK = 128
PROJ_WIDTH = 4 * MLSTM_WIDTH + 2 * N_MLSTM_HEADS + 3 * SB_WIDTH
PROJ_SPLITS = (2 * MLSTM_WIDTH, 3 * MLSTM_WIDTH, 4 * MLSTM_WIDTH,
               4 * MLSTM_WIDTH + N_MLSTM_HEADS, 4 * MLSTM_WIDTH + 2 * N_MLSTM_HEADS)
MEM_TOKENS = 256
N_XATTN_HEADS = 4
XATTN_HEAD_DIM = D_MODEL // N_XATTN_HEADS
PEER_HEADS = 8
PEER_N_KEYS = 128
PEER_N_EXPERTS = PEER_N_KEYS * PEER_N_KEYS
PEER_TOPK = 16
PEER_QUERY_DIM = 256
PEER_HALF = PEER_QUERY_DIM // 2
PEER_CHUNK = 128
EPS = 1e-6

kernel_name = 'hymba_mlstm_stickbreak_peer_block'


def rms_norm(x, g):
    xf = x.astype(jnp.float32)
    y = xf * lax.rsqrt(jnp.mean(xf * xf, axis=-1, keepdims=True) + EPS) * g.astype(jnp.float32)
    return y.astype(x.dtype)


def head_rms_norm(a, g):
    H, dh = a.shape[1], a.shape[3]
    y = a * lax.rsqrt(jnp.mean(a * a, axis=-1, keepdims=True) + EPS)
    return y * g.astype(jnp.float32).reshape(H, 1, dh)


def split_heads(a, n):
    B_, S, W = a.shape
    return a.reshape(B_, S, n, W // n).transpose(0, 2, 1, 3)


def merge_heads(a):
    B_, H, S, dh = a.shape
    return a.transpose(0, 2, 1, 3).reshape(B_, S, H * dh)


def causal_depthwise_conv(a, w, b):
    C = a.shape[-1]
    out = lax.conv_general_dilated(a, w[:, None, :].astype(a.dtype), window_strides=(1,),
                                   padding=[(CONV_WIDTH - 1, 0)],
                                   dimension_numbers=('NWC', 'WIO', 'NWC'),
                                   feature_group_count=C)
    return out + b.astype(a.dtype)


def mlstm_chunkwise(q, k, v, log_i, log_f):
    B_, H, S, dh = q.shape
    L = MLSTM_CHUNK
    nc = S // L

    def to_chunks(a):
        return jnp.moveaxis(a.reshape(B_, H, nc, L, *a.shape[3:]), 2, 0)

    xs = (to_chunks(q), to_chunks(k), to_chunks(v), to_chunks(log_i), to_chunks(log_f))
    causal = jnp.tril(jnp.ones((L, L), dtype=bool))

    def step(carry, inp):
        C, n, m = carry
        qb, kb, vb, ib, fb = inp
        b = jnp.cumsum(fb, axis=-1)
        g = b + m[..., None]
        Dm = jnp.where(causal, b[..., :, None] - b[..., None, :] + ib[..., None, :], -jnp.inf)
        m_t = jnp.maximum(g, jnp.max(Dm, axis=-1))
        W = jnp.exp(Dm - m_t[..., None])
        inter = jnp.exp(g - m_t)
        qk = jnp.einsum('bhtd,bhsd->bhts', qb, kb) * W
        num = inter[..., None] * jnp.einsum('bhvk,bhtk->bhtv', C, qb) + jnp.einsum('bhts,bhsv->bhtv', qk, vb)
        den = inter * jnp.einsum('bhk,bhtk->bht', n, qb) + jnp.sum(qk, axis=-1)
        h = num / jnp.maximum(jnp.abs(den), jnp.exp(-m_t))[..., None]
        F = b[..., -1]
        a = F[..., None] - b + ib
        m_new = jnp.maximum(F + m, jnp.max(a, axis=-1))
        decay = jnp.exp(F + m - m_new)
        w_s = jnp.exp(a - m_new[..., None])
        C_new = decay[..., None, None] * C + jnp.einsum('bhsv,bhsk->bhvk', vb * w_s[..., None], kb)
        n_new = decay[..., None] * n + jnp.einsum('bhs,bhsk->bhk', w_s, kb)
        return (C_new, n_new, m_new), h

    init = (jnp.zeros((B_, H, dh, dh), jnp.float32), jnp.zeros((B_, H, dh), jnp.float32),
            jnp.zeros((B_, H), jnp.float32))
    _, hs = lax.scan(step, init, xs)
    return jnp.moveaxis(hs, 0, 2).reshape(B_, H, S, dh)


def stick_breaking_attention(q, k, v):
    B_, H, S, dh = q.shape
    L = SB_BLOCK
    scale = dh ** -0.5
    outs = []
    for blk in range(S // L):
        n_prefix = (blk + 1) * L
        q_blk = q[:, :, blk * L:(blk + 1) * L]
        k_pre = k[:, :, :n_prefix]
        v_pre = v[:, :, :n_prefix]
        z = jnp.einsum('bhtd,bhsd->bhts', q_blk, k_pre) * scale
        t_idx = blk * L + jnp.arange(L)[:, None]
        s_idx = jnp.arange(n_prefix)[None, :]
        strict = s_idx < t_idx
        log_1m_beta = jnp.where(strict, jax.nn.log_sigmoid(-z), 0.0)
        log_a = z + lax.cumsum(log_1m_beta, axis=3, reverse=True)
        A = jnp.exp(jnp.where(strict, log_a, -jnp.inf))
        outs.append(jnp.einsum('bhts,bhsd->bhtd', A, v_pre))
    return jnp.concatenate(outs, axis=2)


def parallel_mixer(h, w_in, conv_w, conv_b, igate_b, fgate_b, mlstm_norm_g, sb_norm_g, w_out):
    dtype = h.dtype
    f32 = jnp.float32
    proj = h @ w_in
    qk_m, v_m, o_m, i_pre, f_pre, qkv_s = jnp.split(proj, PROJ_SPLITS, axis=-1)
    qk_m = jax.nn.silu(causal_depthwise_conv(qk_m, conv_w, conv_b))
    q_m, k_m = jnp.split(qk_m, 2, axis=-1)
    q_m = split_heads(q_m, N_MLSTM_HEADS).astype(f32)
    k_m = split_heads(k_m, N_MLSTM_HEADS).astype(f32) * (MLSTM_HEAD_DIM ** -0.5)
    v_m = split_heads(v_m, N_MLSTM_HEADS).astype(f32)
    log_i = jnp.swapaxes((i_pre + igate_b).astype(f32), 1, 2)
    log_f = jax.nn.log_sigmoid(jnp.swapaxes((f_pre + fgate_b).astype(f32), 1, 2))
    h_m = mlstm_chunkwise(q_m, k_m, v_m, log_i, log_f)
    h_m = jax.nn.sigmoid(split_heads(o_m, N_MLSTM_HEADS).astype(f32)) * h_m
    h_m = head_rms_norm(h_m, mlstm_norm_g)
    q_s, k_s, v_s = jnp.split(qkv_s, 3, axis=-1)
    h_s = stick_breaking_attention(split_heads(q_s, N_SB_HEADS).astype(f32),
                                   split_heads(k_s, N_SB_HEADS).astype(f32),
                                   split_heads(v_s, N_SB_HEADS).astype(f32))
    h_s = head_rms_norm(h_s, sb_norm_g)
    mixed = jnp.concatenate([merge_heads(h_m), merge_heads(h_s)], axis=-1).astype(dtype)
    return mixed @ w_out


def memory_cross_attention(h, mem_n, wq, wkv, wo):
    B_, S, _ = h.shape
    M = mem_n.shape[1]
    q = (h @ wq).reshape(B_, S, N_XATTN_HEADS, XATTN_HEAD_DIM).astype(jnp.float32)
    k, v = jnp.split(mem_n @ wkv, 2, axis=-1)
    k = k.reshape(B_, M, N_XATTN_HEADS, XATTN_HEAD_DIM).astype(jnp.float32)
    v = v.reshape(B_, M, N_XATTN_HEADS, XATTN_HEAD_DIM).astype(jnp.float32)
    p = jax.nn.softmax(jnp.einsum('bshd,bmhd->bhsm', q, k) * (XATTN_HEAD_DIM ** -0.5), axis=-1)
    o = jnp.einsum('bhsm,bmhd->bshd', p, v).reshape(B_, S, N_XATTN_HEADS * XATTN_HEAD_DIM)
    return o.astype(h.dtype) @ wo


def peer_ffn(h, wq, subkeys, u, v):
    B_, S, D = h.shape
    T = B_ * S
    xt = h.reshape(T, D)
    q = (xt @ wq).reshape(T, PEER_HEADS, 2, PEER_HALF)
    s = jnp.einsum('thpc,hpnc->thpn', q, subkeys).astype(jnp.float32)
    s_top, i_top = lax.top_k(s, PEER_TOPK)
    cand = s_top[:, :, 0, :, None] + s_top[:, :, 1, None, :]
    cand_idx = i_top[:, :, 0, :, None] * PEER_N_KEYS + i_top[:, :, 1, None, :]
    best, pos = lax.top_k(cand.reshape(T, PEER_HEADS, PEER_TOPK * PEER_TOPK), PEER_TOPK)
    experts = jnp.take_along_axis(cand_idx.reshape(T, PEER_HEADS, PEER_TOPK * PEER_TOPK), pos, axis=-1)
    gates = jax.nn.softmax(best, axis=-1).astype(h.dtype)
    nb = T // PEER_CHUNK
    E = PEER_HEADS * PEER_TOPK

    def block(args):
        xb, eb, gb = args
        ub = u[eb]
        vb = v[eb]
        act = jax.nn.gelu(jnp.einsum('cd,ced->ce', xb, ub), approximate=False) * gb
        return jnp.einsum('ce,ced->cd', act, vb)

    y = lax.map(block, (xt.reshape(nb, PEER_CHUNK, D), experts.reshape(nb, PEER_CHUNK, E),
                        gates.reshape(nb, PEER_CHUNK, E)))
    return y.reshape(B_, S, D)


def setup_inputs(seed: int = 0) -> dict:
    key = jax.random.key(seed)
    ks = jax.random.split(key, 24)
    f32 = jnp.float32

    def nrm(k, shape, scale):
        return jax.random.normal(k, shape, f32) * scale

    def gain(k, shape):
        return 1.0 + 0.02 * jax.random.normal(k, shape, f32)

    return {
        'x': nrm(ks[0], (BATCH, SEQ, D_MODEL), 1.0),
        'mem': nrm(ks[1], (BATCH, MEM_TOKENS, D_MODEL), 1.0),
        'mix_norm_g': gain(ks[2], (DEPTH, D_MODEL)),
        'w_in': nrm(ks[3], (DEPTH, D_MODEL, PROJ_WIDTH), D_MODEL ** -0.5),
        'conv_w': nrm(ks[4], (DEPTH, CONV_WIDTH, 2 * MLSTM_WIDTH), CONV_WIDTH ** -0.5),
        'conv_b': nrm(ks[5], (DEPTH, 2 * MLSTM_WIDTH), 0.02),
        'igate_b': nrm(ks[6], (DEPTH, N_MLSTM_HEADS), 0.1),
        'fgate_b': jnp.linspace(3.0, 6.0, N_MLSTM_HEADS, dtype=f32)[None, :] + nrm(ks[7], (DEPTH, N_MLSTM_HEADS), 0.1),
        'mlstm_norm_g': gain(ks[8], (DEPTH, MLSTM_WIDTH)),
        'sb_norm_g': gain(ks[9], (DEPTH, SB_WIDTH)),
        'w_out': nrm(ks[10], (DEPTH, MIX_WIDTH, D_MODEL), MIX_WIDTH ** -0.5),
        'xattn_norm_g': gain(ks[11], (DEPTH, D_MODEL)),
        'mem_norm_g': gain(ks[12], (DEPTH, D_MODEL)),
        'xattn_wq': nrm(ks[13], (DEPTH, D_MODEL, D_MODEL), D_MODEL ** -0.5),
        'xattn_wkv': nrm(ks[14], (DEPTH, D_MODEL, 2 * D_MODEL), D_MODEL ** -0.5),
        'xattn_wo': nrm(ks[15], (DEPTH, D_MODEL, D_MODEL), D_MODEL ** -0.5),
        'ffn_norm_g': gain(ks[16], (DEPTH, D_MODEL)),
        'peer_wq': nrm(ks[17], (DEPTH, D_MODEL, PEER_HEADS * PEER_QUERY_DIM), D_MODEL ** -0.5),
        'peer_subkeys': nrm(ks[18], (DEPTH, PEER_HEADS, 2, PEER_N_KEYS, PEER_HALF), PEER_HALF ** -0.5),
        'peer_u': nrm(ks[19], (DEPTH, PEER_N_EXPERTS, D_MODEL), D_MODEL ** -0.5),
        'peer_v': nrm(ks[20], (DEPTH, PEER_N_EXPERTS, D_MODEL), (PEER_HEADS * PEER_TOPK) ** -0.5),
        'final_norm_g': gain(ks[21], (D_MODEL,)),
    }


def reference(x, mem, mix_norm_g, w_in, conv_w, conv_b, igate_b, fgate_b, mlstm_norm_g, sb_norm_g,
              w_out, xattn_norm_g, mem_norm_g, xattn_wq, xattn_wkv, xattn_wo, ffn_norm_g, peer_wq,
              peer_subkeys, peer_u, peer_v, final_norm_g):
    for l in range(DEPTH):
        x = x + parallel_mixer(rms_norm(x, mix_norm_g[l]), w_in[l], conv_w[l], conv_b[l], igate_b[l],
                               fgate_b[l], mlstm_norm_g[l], sb_norm_g[l], w_out[l])
        x = x + memory_cross_attention(rms_norm(x, xattn_norm_g[l]), rms_norm(mem, mem_norm_g[l]),
                                       xattn_wq[l], xattn_wkv[l], xattn_wo[l])
        x = x + peer_ffn(rms_norm(x, ffn_norm_g[l]), peer_wq[l], peer_subkeys[l], peer_u[l], peer_v[l])
    return rms_norm(x, final_norm_g)
```

```cpp
#include <hip/hip_runtime.h>
#include <cstdio>
#include <cstdint>
#include <cmath>
namespace nv {
constexpr int T = 32768, D = 1024, S = 4096, NB = 8;
constexpr int PROJ_W = 3592;
constexpr float EPS = 1e-6f;

__device__ __forceinline__ float wave_sum(float v) {
#pragma unroll
    for (int o = 1; o < 64; o <<= 1) v += __shfl_xor(v, o);
    return v;
}
__device__ __forceinline__ float wave_max(float v) {
#pragma unroll
    for (int o = 1; o < 64; o <<= 1) v = fmaxf(v, __shfl_xor(v, o));
    return v;
}
__device__ __forceinline__ float log_sigmoid(float x) { return fminf(x, 0.f) - log1pf(expf(-fabsf(x))); }

__global__ __launch_bounds__(256) void k_rmsnorm(const float* __restrict__ x, const float* __restrict__ g, float* __restrict__ y, int rows) {
    const int row = blockIdx.x * 4 + (threadIdx.x >> 6), lane = threadIdx.x & 63;
    if (row >= rows) return;
    const float4* xr = (const float4*)(x + (size_t)row * 1024);
    const float4* gr = (const float4*)g;
    float4 v[4]; float s = 0.f;
#pragma unroll
    for (int j = 0; j < 4; ++j) { v[j] = xr[lane + 64 * j]; s += v[j].x * v[j].x + v[j].y * v[j].y + v[j].z * v[j].z + v[j].w * v[j].w; }
    s = wave_sum(s);
    const float r = rsqrtf(s * (1.f / 1024.f) + EPS);
    float4* yr = (float4*)(y + (size_t)row * 1024);
#pragma unroll
    for (int j = 0; j < 4; ++j) { const float4 gg = gr[lane + 64 * j]; float4 o; o.x = v[j].x * r * gg.x; o.y = v[j].y * r * gg.y; o.z = v[j].z * r * gg.z; o.w = v[j].w * r * gg.w; yr[lane + 64 * j] = o; }
}

__global__ __launch_bounds__(256) void k_gemm(const float* __restrict__ A, int lda, const float* __restrict__ B, int ldb, float* __restrict__ C, int ldc,
                                              const float* __restrict__ R, int ldr, int M, int N, int K) {
    __shared__ float As[16][68];
    __shared__ float Bs[16][68];
    const int tid = threadIdx.x, tx = tid & 15, ty = tid >> 4;
    const int m0 = blockIdx.y * 64, n0 = blockIdx.x * 64;
    float acc[4][4];
#pragma unroll
    for (int i = 0; i < 4; ++i)
#pragma unroll
        for (int j = 0; j < 4; ++j) acc[i][j] = 0.f;
    const int ar = tid >> 2, ak = (tid & 3) * 4;
    const int bk = tid >> 4, bn = (tid & 15) * 4;
    for (int k0 = 0; k0 < K; k0 += 16) {
        const float4 av = *(const float4*)(A + (size_t)(m0 + ar) * lda + k0 + ak);
        As[ak + 0][ar] = av.x; As[ak + 1][ar] = av.y; As[ak + 2][ar] = av.z; As[ak + 3][ar] = av.w;
        const float* bp = B + (size_t)(k0 + bk) * ldb + n0 + bn;
        float4 bv;
        if (n0 + bn + 3 < N) bv = *(const float4*)bp;
        else { bv.x = (n0 + bn + 0 < N) ? bp[0] : 0.f; bv.y = (n0 + bn + 1 < N) ? bp[1] : 0.f; bv.z = (n0 + bn + 2 < N) ? bp[2] : 0.f; bv.w = (n0 + bn + 3 < N) ? bp[3] : 0.f; }
        Bs[bk][bn + 0] = bv.x; Bs[bk][bn + 1] = bv.y; Bs[bk][bn + 2] = bv.z; Bs[bk][bn + 3] = bv.w;
        __syncthreads();
#pragma unroll
        for (int kk = 0; kk < 16; ++kk) {
            float a[4], b[4];
#pragma unroll
            for (int i = 0; i < 4; ++i) { a[i] = As[kk][ty * 4 + i]; b[i] = Bs[kk][tx * 4 + i]; }
#pragma unroll
            for (int i = 0; i < 4; ++i)
#pragma unroll
                for (int j = 0; j < 4; ++j) acc[i][j] += a[i] * b[j];
        }
        __syncthreads();
    }
#pragma unroll
    for (int i = 0; i < 4; ++i)
#pragma unroll
        for (int j = 0; j < 4; ++j) {
            const int m = m0 + ty * 4 + i, n = n0 + tx * 4 + j;
            if (n < N) { float v = acc[i][j]; if (R) v += R[(size_t)m * ldr + n]; C[(size_t)m * ldc + n] = v; }
        }
}

__global__ __launch_bounds__(256) void k_conv_silu(const float* __restrict__ in, const float* __restrict__ w, int wld, int coff, const float* __restrict__ bias, float* __restrict__ out, int C) {
    const size_t idx = (size_t)blockIdx.x * 256 + threadIdx.x;
    const int c = (int)(idx % C); const int t = (int)(idx / C); if (t >= T) return;
    const int ts = t % S;
    float a = bias[coff + c];
#pragma unroll
    for (int j = 0; j < 4; ++j) { const int tt = ts - 3 + j; if (tt >= 0) a += w[j * wld + coff + c] * in[(size_t)(t - 3 + j) * C + c]; }
    out[idx] = a / (1.f + expf(-a));
}

__global__ __launch_bounds__(256) void k_mlstm(const float* __restrict__ q, const float* __restrict__ k, const float* __restrict__ v, const float* __restrict__ gates,
                                               const float* __restrict__ igb, const float* __restrict__ fgb, float* __restrict__ hout, float* scratch) {
    const int bh = blockIdx.x, b = bh >> 2, h = bh & 3, tid = threadIdx.x;
    float* Cst = scratch + (size_t)bh * (32768 + 256); float* QK = Cst + 16384; float* nvec = QK + 16384;
    __shared__ float sb[128], sib[128], sfb[128], smt[128], sinter[128], sden[128], sws[128];
    __shared__ float sm, sF, smnew, sdecay;
    const float kscale = 0.08838834764831845f;
    for (int i = tid; i < 16384; i += 256) Cst[i] = 0.f;
    if (tid < 128) nvec[tid] = 0.f;
    if (tid == 0) sm = 0.f;
    __syncthreads();
    for (int c = 0; c < 32; ++c) {
        const size_t t0 = (size_t)b * S + (size_t)c * 128;
        if (tid < 128) { sib[tid] = gates[(t0 + tid) * 8 + h] + igb[h]; sfb[tid] = log_sigmoid(gates[(t0 + tid) * 8 + 4 + h] + fgb[h]); }
        __syncthreads();
        if (tid == 0) { float a = 0.f; for (int i = 0; i < 128; ++i) { a += sfb[i]; sb[i] = a; } }
        __syncthreads();
        const float m = sm;
        if (tid < 128) { const int t = tid; const float g = sb[t] + m; float mx = -INFINITY; for (int s = 0; s <= t; ++s) mx = fmaxf(mx, sb[t] - sb[s] + sib[s]);
            const float mt = fmaxf(g, mx); smt[t] = mt; sinter[t] = expf(g - mt); }
        __syncthreads();
        for (int idx = tid; idx < 16384; idx += 256) { const int t = idx >> 7, s = idx & 127; float val = 0.f;
            if (s <= t) { const float* qp = q + (t0 + t) * 512 + h * 128; const float* kp = k + (t0 + s) * 512 + h * 128; float d = 0.f; for (int kk = 0; kk < 128; ++kk) d += qp[kk] * kp[kk];
                val = d * kscale * expf(sb[t] - sb[s] + sib[s] - smt[t]); }
            QK[idx] = val; }
        __syncthreads();
        if (tid < 128) { const int t = tid; const float* qp = q + (t0 + t) * 512 + h * 128; float dn = 0.f; for (int kk = 0; kk < 128; ++kk) dn += nvec[kk] * qp[kk];
            float rs = 0.f; for (int s = 0; s < 128; ++s) rs += QK[t * 128 + s]; sden[t] = sinter[t] * dn + rs; }
        __syncthreads();
        for (int idx = tid; idx < 16384; idx += 256) { const int t = idx >> 7, vv = idx & 127; const float* qp = q + (t0 + t) * 512 + h * 128;
            float cq = 0.f; for (int kk = 0; kk < 128; ++kk) cq += Cst[vv * 128 + kk] * qp[kk];
            float pv = 0.f; for (int s = 0; s <= t; ++s) pv += QK[t * 128 + s] * v[(t0 + s) * 512 + h * 128 + vv];
            const float num = sinter[t] * cq + pv;
            hout[(t0 + t) * 512 + h * 128 + vv] = num / fmaxf(fabsf(sden[t]), expf(-smt[t])); }
        __syncthreads();
        if (tid == 0) { const float F = sb[127]; float mx = -INFINITY; for (int s = 0; s < 128; ++s) mx = fmaxf(mx, F - sb[s] + sib[s]);
            const float mnew = fmaxf(F + m, mx); sdecay = expf(F + m - mnew); smnew = mnew; sF = F; }
        __syncthreads();
        if (tid < 128) sws[tid] = expf(sF - sb[tid] + sib[tid] - smnew);
        __syncthreads();
        for (int idx = tid; idx < 16384; idx += 256) { const int vv = idx >> 7, kk = idx & 127; float a = 0.f;
            for (int s = 0; s < 128; ++s) a += sws[s] * v[(t0 + s) * 512 + h * 128 + vv] * k[(t0 + s) * 512 + h * 128 + kk];
            Cst[idx] = sdecay * Cst[idx] + a * kscale; }
        if (tid < 128) { const int kk = tid; float a = 0.f; for (int s = 0; s < 128; ++s) a += sws[s] * k[(t0 + s) * 512 + h * 128 + kk]; nvec[kk] = sdecay * nvec[kk] + a * kscale; }
        __syncthreads();
        if (tid == 0) sm = smnew;
        __syncthreads();
    }
}

__global__ __launch_bounds__(64) void k_sb(const float* __restrict__ q, const float* __restrict__ k, const float* __restrict__ v, float* __restrict__ out) {
    const int blk = blockIdx.x, qt = blk & 63, bh = blk >> 6, b = bh >> 3, h = bh & 7;
    const int t = qt * 64 + threadIdx.x;
    const float* qp = q + ((size_t)b * S + t) * 512 + h * 64;
    float qr[64], o[64];
#pragma unroll
    for (int d = 0; d < 64; ++d) { qr[d] = qp[d]; o[d] = 0.f; }
    float cum = 0.f;
    for (int s = qt * 64 + 62; s >= 0; --s) {
        const float* kp = k + ((size_t)b * S + s) * 512 + h * 64;
        const float* vp = v + ((size_t)b * S + s) * 512 + h * 64;
        float z = 0.f;
#pragma unroll
        for (int d = 0; d < 64; ++d) z += qr[d] * kp[d];
        z *= 0.125f;
        if (s < t) {
            cum += log_sigmoid(-z);
            const float a = expf(z + cum);
#pragma unroll
            for (int d = 0; d < 64; ++d) o[d] += a * vp[d];
        }
    }
    float* op = out + ((size_t)b * S + t) * 512 + h * 64;
#pragma unroll
    for (int d = 0; d < 64; ++d) op[d] = o[d];
}

__global__ __launch_bounds__(256) void k_headnorm(const float* __restrict__ hin, const float* __restrict__ gate, const float* __restrict__ g, float* __restrict__ out, int ooff, int nh, int dh) {
    const int w = blockIdx.x * 4 + (threadIdx.x >> 6), lane = threadIdx.x & 63;
    const int t = w / nh, h = w % nh; if (t >= T) return;
    const int per = dh >> 6; float x0 = 0.f, x1 = 0.f; float s = 0.f;
    { const int i = lane; float a = hin[(size_t)t * 512 + h * dh + i]; if (gate) { const float gt = gate[(size_t)t * 512 + h * dh + i]; a *= 1.f / (1.f + expf(-gt)); } x0 = a; s += a * a; }
    if (per > 1) { const int i = lane + 64; float a = hin[(size_t)t * 512 + h * dh + i]; if (gate) { const float gt = gate[(size_t)t * 512 + h * dh + i]; a *= 1.f / (1.f + expf(-gt)); } x1 = a; s += a * a; }
    s = wave_sum(s);
    const float r = rsqrtf(s / (float)dh + EPS);
    out[(size_t)t * 1024 + ooff + h * dh + lane] = x0 * r * g[h * dh + lane];
    if (per > 1) out[(size_t)t * 1024 + ooff + h * dh + lane + 64] = x1 * r * g[h * dh + lane + 64];
}

__global__ __launch_bounds__(256) void k_xattn(const float* __restrict__ q, const float* __restrict__ kv, float* __restrict__ o) {
    const int t = blockIdx.x, b = t >> 12, h = threadIdx.x >> 6, lane = threadIdx.x & 63;
    __shared__ float sq[4][256]; __shared__ float sp[4][256];
#pragma unroll
    for (int j = 0; j < 4; ++j) sq[h][lane + 64 * j] = q[(size_t)t * 1024 + h * 256 + lane + 64 * j];
    __syncthreads();
    float sc[4]; float mx = -INFINITY;
#pragma unroll
    for (int i = 0; i < 4; ++i) { const int m = lane + 64 * i; const float* kp = kv + (size_t)(b * 256 + m) * 2048 + h * 256; float d = 0.f; for (int dd = 0; dd < 256; ++dd) d += sq[h][dd] * kp[dd]; sc[i] = d * 0.0625f; mx = fmaxf(mx, sc[i]); }
    mx = wave_max(mx);
    float sum = 0.f;
#pragma unroll
    for (int i = 0; i < 4; ++i) { sc[i] = expf(sc[i] - mx); sum += sc[i]; }
    sum = wave_sum(sum);
#pragma unroll
    for (int i = 0; i < 4; ++i) sp[h][lane + 64 * i] = sc[i] / sum;
    __syncthreads();
    float acc[4] = {0.f, 0.f, 0.f, 0.f};
    for (int m = 0; m < 256; ++m) { const float p = sp[h][m]; const float* vp = kv + (size_t)(b * 256 + m) * 2048 + 1024 + h * 256;
#pragma unroll
        for (int j = 0; j < 4; ++j) acc[j] += p * vp[lane + 64 * j]; }
#pragma unroll
    for (int j = 0; j < 4; ++j) o[(size_t)t * 1024 + h * 256 + lane + 64 * j] = acc[j];
}

__global__ __launch_bounds__(256) void k_peer(const float* __restrict__ hn2, const float* __restrict__ qp, const float* __restrict__ subkeys, const float* __restrict__ u, const float* __restrict__ vv, float* x2) {
    const int t = blockIdx.x, tid = threadIdx.x, wave = tid >> 6, lane = tid & 63;
    __shared__ float ss[256]; __shared__ float stv[2][16]; __shared__ int sti[2][16]; __shared__ float sg[16]; __shared__ int se[16];
    __shared__ float sx[1024]; __shared__ float sy[4][1024];
#pragma unroll
    for (int j = 0; j < 4; ++j) sx[tid + 256 * j] = hn2[(size_t)t * 1024 + tid + 256 * j];
    float yacc[16];
#pragma unroll
    for (int j = 0; j < 16; ++j) yacc[j] = 0.f;
    __syncthreads();
    for (int h = 0; h < 8; ++h) {
        { const int p = tid >> 7, n = tid & 127; const float* qv = qp + (size_t)t * 2048 + h * 256 + p * 128; const float* sk = subkeys + ((size_t)(h * 2 + p) * 128 + n) * 128;
          float d = 0.f; for (int c = 0; c < 128; ++c) d += qv[c] * sk[c]; ss[tid] = d; }
        __syncthreads();
        if (tid == 0 || tid == 128) { const int p = tid >> 7;
            for (int r = 0; r < 16; ++r) { float best = -INFINITY; int bi = 0; for (int n = 0; n < 128; ++n) { const float val = ss[p * 128 + n]; if (val > best) { best = val; bi = n; } }
                stv[p][r] = best; sti[p][r] = bi; ss[p * 128 + bi] = -INFINITY; } }
        __syncthreads();
        ss[tid] = stv[0][tid >> 4] + stv[1][tid & 15];
        __syncthreads();
        if (tid == 0) { float mx = -INFINITY;
            for (int r = 0; r < 16; ++r) { float best = -INFINITY; int bi = 0; for (int n = 0; n < 256; ++n) { const float val = ss[n]; if (val > best) { best = val; bi = n; } }
                sg[r] = best; se[r] = sti[0][bi >> 4] * 128 + sti[1][bi & 15]; ss[bi] = -INFINITY; mx = fmaxf(mx, best); }
            float sum = 0.f; for (int r = 0; r < 16; ++r) { const float e = expf(sg[r] - mx); sg[r] = e; sum += e; }
            for (int r = 0; r < 16; ++r) sg[r] /= sum; }
        __syncthreads();
        for (int jj = 0; jj < 4; ++jj) { const int ei = se[wave + 4 * jj]; const float g = sg[wave + 4 * jj];
            const float* up = u + (size_t)ei * 1024; const float* vp = vv + (size_t)ei * 1024;
            float d = 0.f;
#pragma unroll
            for (int j = 0; j < 16; ++j) { const int i = lane + 64 * j; d += sx[i] * up[i]; }
            d = wave_sum(d);
            const float act = 0.5f * d * (1.f + erff(d * 0.70710678118654752f)) * g;
#pragma unroll
            for (int j = 0; j < 16; ++j) { const int i = lane + 64 * j; yacc[j] += act * vp[i]; } }
        __syncthreads();
    }
#pragma unroll
    for (int j = 0; j < 16; ++j) sy[wave][lane + 64 * j] = yacc[j];
    __syncthreads();
#pragma unroll
    for (int j = 0; j < 4; ++j) { const int i = tid + 256 * j; x2[(size_t)t * 1024 + i] += sy[0][i] + sy[1][i] + sy[2][i] + sy[3][i]; }
}

struct In {
    const float *x, *mem, *mix_norm_g, *w_in, *conv_w, *conv_b, *igate_b, *fgate_b, *mlstm_norm_g, *sb_norm_g, *w_out, *xattn_norm_g, *mem_norm_g,
        *xattn_wq, *xattn_wkv, *xattn_wo, *ffn_norm_g, *peer_wq, *peer_subkeys, *peer_u, *peer_v, *final_norm_g;
};

static inline void gemm(hipStream_t st, const float* A, int lda, const float* B, int ldb, float* C, int ldc, const float* R, int ldr, int M, int N, int K) {
    dim3 grid((N + 63) / 64, M / 64);
    hipLaunchKernelGGL(k_gemm, grid, dim3(256), 0, st, A, lda, B, ldb, C, ldc, R, ldr, M, N, K);
}

static void forward(const In& in, float* out, unsigned char* ws, hipStream_t st) {
    const size_t MB = 1u << 20;
    float* R0 = (float*)(ws + 1 * MB);
    float* R1 = (float*)(ws + 129 * MB);
    float* R2 = (float*)(ws + 257 * MB);
    float* R3 = (float*)(ws + 385 * MB);
    float* hn = out;
    float* mixed = R0;
    float* tmp = R1; float* qm = R1 + (size_t)T * 512; float* km = R2; float* vm = R2 + (size_t)T * 512; float* om = R3;
    float* gates = R3 + (size_t)T * 512; float* mscr = gates + (size_t)T * 8;
    hipLaunchKernelGGL(k_rmsnorm, dim3(T / 4), dim3(256), 0, st, in.x, in.mix_norm_g, hn, T);
    gemm(st, hn, 1024, in.w_in + 0, PROJ_W, tmp, 512, nullptr, 0, T, 512, 1024);
    hipLaunchKernelGGL(k_conv_silu, dim3(T * 512 / 256), dim3(256), 0, st, tmp, in.conv_w, 1024, 0, in.conv_b, qm, 512);
    gemm(st, hn, 1024, in.w_in + 512, PROJ_W, tmp, 512, nullptr, 0, T, 512, 1024);
    hipLaunchKernelGGL(k_conv_silu, dim3(T * 512 / 256), dim3(256), 0, st, tmp, in.conv_w, 1024, 512, in.conv_b, km, 512);
    gemm(st, hn, 1024, in.w_in + 1024, PROJ_W, vm, 512, nullptr, 0, T, 512, 1024);
    gemm(st, hn, 1024, in.w_in + 1536, PROJ_W, om, 512, nullptr, 0, T, 512, 1024);
    gemm(st, hn, 1024, in.w_in + 2048, PROJ_W, gates, 8, nullptr, 0, T, 8, 1024);
    hipLaunchKernelGGL(k_mlstm, dim3(32), dim3(256), 0, st, qm, km, vm, gates, in.igate_b, in.fgate_b, tmp, mscr);
    hipLaunchKernelGGL(k_headnorm, dim3(T * 4 / 4), dim3(256), 0, st, tmp, om, in.mlstm_norm_g, mixed, 0, 4, 128);
    float* qs = R1; float* ks = R1 + (size_t)T * 512; float* vs = R2; float* hs = R2 + (size_t)T * 512;
    gemm(st, hn, 1024, in.w_in + 2056, PROJ_W, qs, 512, nullptr, 0, T, 512, 1024);
    gemm(st, hn, 1024, in.w_in + 2056 + 512, PROJ_W, ks, 512, nullptr, 0, T, 512, 1024);
    gemm(st, hn, 1024, in.w_in + 2056 + 1024, PROJ_W, vs, 512, nullptr, 0, T, 512, 1024);
    hipLaunchKernelGGL(k_sb, dim3(NB * 8 * 64), dim3(64), 0, st, qs, ks, vs, hs);
    hipLaunchKernelGGL(k_headnorm, dim3(T * 8 / 4), dim3(256), 0, st, hs, (const float*)nullptr, in.sb_norm_g, mixed, 512, 8, 64);
    float* x1 = R1;
    gemm(st, mixed, 1024, in.w_out, 1024, x1, 1024, in.x, 1024, T, 1024, 1024);
    float* hn1 = out; float* qx = R2; float* memn = R3; float* kvx = R3 + (size_t)2048 * 1024; float* ox = R0;
    hipLaunchKernelGGL(k_rmsnorm, dim3(T / 4), dim3(256), 0, st, x1, in.xattn_norm_g, hn1, T);
    hipLaunchKernelGGL(k_rmsnorm, dim3(2048 / 4), dim3(256), 0, st, in.mem, in.mem_norm_g, memn, 2048);
    gemm(st, hn1, 1024, in.xattn_wq, 1024, qx, 1024, nullptr, 0, T, 1024, 1024);
    gemm(st, memn, 1024, in.xattn_wkv, 2048, kvx, 2048, nullptr, 0, 2048, 2048, 1024);
    hipLaunchKernelGGL(k_xattn, dim3(T), dim3(256), 0, st, qx, kvx, ox);
    float* x2 = R2;
    gemm(st, ox, 1024, in.xattn_wo, 1024, x2, 1024, x1, 1024, T, 1024, 1024);
    float* hn2 = out; float* qp = R0;
    hipLaunchKernelGGL(k_rmsnorm, dim3(T / 4), dim3(256), 0, st, x2, in.ffn_norm_g, hn2, T);
    gemm(st, hn2, 1024, in.peer_wq, 2048, qp, 2048, nullptr, 0, T, 2048, 1024);
    hipLaunchKernelGGL(k_peer, dim3(T), dim3(256), 0, st, hn2, qp, in.peer_subkeys, in.peer_u, in.peer_v, x2);
    hipLaunchKernelGGL(k_rmsnorm, dim3(T / 4), dim3(256), 0, st, x2, in.final_norm_g, out, T);
}
}

extern "C" void kernel_launch(void* const* d_in, const int* in_sizes, int n_in, void* d_out, int out_size, void* d_ws, size_t ws_size, hipStream_t stream) {
    if (n_in != 22 || ws_size < (size_t)511 * 1024 * 1024) { fprintf(stderr, "kernel_launch: unexpected n_in %d / ws %zu\n", n_in, ws_size); return; }
    nv::In in;
    const float** p = (const float**)&in;
    for (int i = 0; i < 22; ++i) p[i] = (const float*)d_in[i];
    nv::forward(in, (float*)d_out, (unsigned char*)d_ws, stream);
}
```

```cpp
#include <hip/hip_runtime.h>
#include <cstdio>
#include <cstdint>
#include <cmath>
#define HYBRID 0
#define HYBRID_ML_NAIVE 0
#define HYBRID_SB_NAIVE 0
#define HYBRID_P5_NAIVE 0
#define HYBRID_P8_NAIVE 0
#define P8_DEBUG 0
#define REPEAT -1
namespace pg8 {
#define PG8_LAS __attribute__((address_space(3)))
typedef unsigned short bf16_t;
typedef short bf16x8 __attribute__((ext_vector_type(8)));
typedef float f32x4 __attribute__((ext_vector_type(4)));
typedef unsigned u32x4 __attribute__((ext_vector_type(4)));
constexpr int BM = 256, BK = 64, HALF = 128, HTB = HALF * BK * 2  , STAGE_BYTES = 8 * HTB, NXCD = 8, WGM = 8;

__host__ __device__ __forceinline__ int lds_byte(int r, int c) { const int st = (r >> 4) * 2 + (c >> 5), rr = r & 15, cc = c & 31, ob = rr * 64 + cc * 2; return st * 1024 + (ob ^ (((ob >> 9) & 1) << 5)); }
__host__ __device__ __forceinline__ void stage_rc(int b, int& R, int& C) { const int st = b / 1024, sb = b % 1024, swz = sb ^ (((sb >> 9) & 1) << 5); R = (st >> 1) * 16 + swz / 64; C = (st & 1) * 32 + (swz % 64) / 2; }
__host__ __device__ __forceinline__ int perm32(int rho) { const int n = rho >> 4, i = rho & 15; return 8 * (i >> 2) + 4 * n + (i & 3); }

struct Unit { int pm, pn; };
struct Gemm { const bf16_t* A; const bf16_t* Bt; int M, N, K; int bshift; size_t bstride; };

struct StaticOrder {
    int nM, nN, nwg, G, c;
    __host__ __device__ void init(int M, int N, int G_, int c_) { nM = M / BM; nN = N / BM; nwg = nM * nN; G = G_; c = c_; }
    __host__ __device__ bool next(int i, Unit& u) const {
        const long L = (long)i * G + c; if (L >= nwg) return false;
        int wgid = (int)L; { const int q = nwg / NXCD, r = nwg % NXCD, xcd = wgid % NXCD, off = wgid / NXCD; wgid = (xcd < r ? xcd * (q + 1) : r * (q + 1) + (xcd - r) * q) + off; }
        const int nig = WGM * nN, gid = wgid / nig, fm = gid * WGM, gsz = (nM - fm) < WGM ? (nM - fm) : WGM;
        u.pm = fm + ((wgid % nig) % gsz); u.pn = (wgid % nig) / gsz; return true;
    }
    __device__ __forceinline__ void a_ready(const Unit&) const {}
    __device__ __forceinline__ void done(const Unit&) const {}
};

__device__ __forceinline__ unsigned cvt_pk_bf16(float lo, float hi) { unsigned r; asm volatile("v_cvt_pk_bf16_f32 %0, %1, %2" : "=v"(r) : "v"(lo), "v"(hi)); return r; }
typedef float f32x2 __attribute__((ext_vector_type(2)));
typedef unsigned u32x2 __attribute__((ext_vector_type(2)));
typedef _Float16 f16x2 __attribute__((ext_vector_type(2)));
__device__ __forceinline__ float xadd16(float r) { float a = r, b = r; asm volatile("s_nop 1\n\tv_permlane16_swap_b32 %0, %1\n\ts_nop 1" : "+v"(a), "+v"(b)); return a + b; }
__device__ __forceinline__ float xadd32(float r) { float a = r, b = r; asm volatile("s_nop 1\n\tv_permlane32_swap_b32 %0, %1\n\ts_nop 1" : "+v"(a), "+v"(b)); return a + b; }
__device__ __forceinline__ float xmax32(float r) { float a = r, b = r; asm volatile("s_nop 1\n\tv_permlane32_swap_b32 %0, %1\n\ts_nop 1" : "+v"(a), "+v"(b)); return fmaxf(a, b); }
__device__ __forceinline__ float xmax16(float r) { float a = r, b = r; asm volatile("s_nop 1\n\tv_permlane16_swap_b32 %0, %1\n\ts_nop 1" : "+v"(a), "+v"(b)); return fmaxf(a, b); }
struct OneUnit {
    int pm, pn;
    __device__ __forceinline__ bool next(int i, Unit& u) const { if (i != 0) return false; u.pm = pm; u.pn = pn; return true; }
    __device__ __forceinline__ void a_ready(const Unit&) const {}
    __device__ __forceinline__ void done(const Unit&) const {}
};
template <bool F16> struct EpiRow {
    static constexpr bool PERM = true, AFTER_DRAIN = false;
    bf16_t* O; int ldc; const float* ssq; int nparts;
    __device__ __forceinline__ void operator()(const f32x4 (&acc)[2][2][4][2], const Unit& u, int wr, int wc, int fr, int fq) const {
        const int row0 = u.pm * BM + wr * 64 + fr; const int col0 = u.pn * BM + wc * 32 + 8 * fq;
#pragma unroll
        for (int ai = 0; ai < 2; ++ai)
#pragma unroll
            for (int m = 0; m < 4; ++m) { const int row = row0 + ai * HALF + m * 16; bf16_t* rowp = O + (size_t)row * ldc + col0;
                float sc = 1.0f;
                if (ssq) { float t = 0.f;
                    if (nparts == 1) t = ssq[row];
                    else { const f32x4* sp = (const f32x4*)(ssq + (size_t)row * 16); const f32x4 a = sp[0], b = sp[1], c = sp[2], d = sp[3]; t = ((a[0] + a[1]) + (a[2] + a[3])) + ((b[0] + b[1]) + (b[2] + b[3])) + ((c[0] + c[1]) + (c[2] + c[3])) + ((d[0] + d[1]) + (d[2] + d[3])); }
                    sc = __builtin_amdgcn_rsqf(t * (1.0f / 1024.0f) + 1e-6f); }
#pragma unroll
                for (int bj = 0; bj < 2; ++bj) { const f32x4 v0 = acc[ai][bj][m][0] * sc, v1 = acc[ai][bj][m][1] * sc; u32x4 w;
                    if (F16) { w.x = __builtin_bit_cast(unsigned, __builtin_amdgcn_cvt_pkrtz(v0[0], v0[1])); w.y = __builtin_bit_cast(unsigned, __builtin_amdgcn_cvt_pkrtz(v0[2], v0[3]));
                               w.z = __builtin_bit_cast(unsigned, __builtin_amdgcn_cvt_pkrtz(v1[0], v1[1])); w.w = __builtin_bit_cast(unsigned, __builtin_amdgcn_cvt_pkrtz(v1[2], v1[3])); }
                    else { w.x = cvt_pk_bf16(v0[0], v0[1]); w.y = cvt_pk_bf16(v0[2], v0[3]); w.z = cvt_pk_bf16(v1[0], v1[1]); w.w = cvt_pk_bf16(v1[2], v1[3]); }
                    *(u32x4*)(rowp + bj * HALF) = w; } }
    }
};
template <bool RB16> struct EpiRes {
    static constexpr bool PERM = true, AFTER_DRAIN = false;
    const void* R; bf16_t* XB; float* ssq; int ldc;
    __device__ __forceinline__ void operator()(const f32x4 (&acc)[2][2][4][2], const Unit& u, int wr, int wc, int fr, int fq) const {
        const int col0 = u.pn * BM + wc * 32 + 8 * fq;
#pragma unroll
        for (int ai = 0; ai < 2; ++ai)
#pragma unroll
            for (int m = 0; m < 4; ++m) { const int row = u.pm * BM + ai * HALF + wr * 64 + m * 16 + fr; const size_t off = (size_t)row * ldc + col0; float s = 0.f;
                f32x4 r[2][2];
#pragma unroll
                for (int bj = 0; bj < 2; ++bj) { const size_t o2 = off + bj * HALF;
                    if (RB16) { const u32x4 w = *(const u32x4*)((const bf16_t*)R + o2);
                        r[bj][0] = (f32x4){__builtin_bit_cast(float, w.x << 16), __builtin_bit_cast(float, w.x & 0xFFFF0000u), __builtin_bit_cast(float, w.y << 16), __builtin_bit_cast(float, w.y & 0xFFFF0000u)};
                        r[bj][1] = (f32x4){__builtin_bit_cast(float, w.z << 16), __builtin_bit_cast(float, w.z & 0xFFFF0000u), __builtin_bit_cast(float, w.w << 16), __builtin_bit_cast(float, w.w & 0xFFFF0000u)}; }
                    else { r[bj][0] = *(const f32x4*)((const float*)R + o2); r[bj][1] = *(const f32x4*)((const float*)R + o2 + 4); } }
#pragma unroll
                for (int bj = 0; bj < 2; ++bj) { const size_t o2 = off + bj * HALF; const f32x4 x0 = r[bj][0] + acc[ai][bj][m][0], x1 = r[bj][1] + acc[ai][bj][m][1];
                    u32x4 w; w.x = cvt_pk_bf16(x0[0], x0[1]); w.y = cvt_pk_bf16(x0[2], x0[3]); w.z = cvt_pk_bf16(x1[0], x1[1]); w.w = cvt_pk_bf16(x1[2], x1[3]); *(u32x4*)(XB + o2) = w;
#pragma unroll
                    for (int k = 0; k < 4; ++k) { const float lo = __builtin_bit_cast(float, w[k] << 16), hi = __builtin_bit_cast(float, w[k] & 0xFFFF0000u); s += lo * lo + hi * hi; } }
                s = xadd16(s); s = xadd32(s);
                if (fq == 0) ssq[(size_t)row * 16 + u.pn * 4 + wc] = s;
                asm volatile("" ::: "memory"); }
    }
};
struct EpiBlk {
    static constexpr bool PERM = true, AFTER_DRAIN = false;
    bf16_t* O; int nbn;
    __device__ __forceinline__ void operator()(const f32x4 (&acc)[2][2][4][2], const Unit& u, int wr, int wc, int fr, int fq) const {
        bf16_t* blk = O + (size_t)(u.pm * nbn + u.pn) * (BM * BM);
        const int row0 = wr * 64 + fr, col0 = wc * 32 + 8 * fq;
#pragma unroll
        for (int ai = 0; ai < 2; ++ai)
#pragma unroll
            for (int m = 0; m < 4; ++m) { bf16_t* rowp = blk + (size_t)(row0 + ai * HALF + m * 16) * BM + col0;
#pragma unroll
                for (int bj = 0; bj < 2; ++bj) { const f32x4 v0 = acc[ai][bj][m][0], v1 = acc[ai][bj][m][1]; u32x4 w;
                    w.x = cvt_pk_bf16(v0[0], v0[1]); w.y = cvt_pk_bf16(v0[2], v0[3]); w.z = cvt_pk_bf16(v1[0], v1[1]); w.w = cvt_pk_bf16(v1[2], v1[3]);
                    *(u32x4*)(rowp + bj * HALF) = w; } }
    }
};
struct EpiSoftmax {
    static constexpr bool PERM = true, AFTER_DRAIN = false;
    bf16_t* O; int ldc; const float* ssq; PG8_LAS float* ex;
    __device__ __forceinline__ void operator()(const f32x4 (&acc)[2][2][4][2], const Unit& u, int wr, int wc, int fr, int fq) const {
#pragma unroll
        for (int ai = 0; ai < 2; ++ai)
#pragma unroll
            for (int m = 0; m < 4; ++m) { const int rl = wr * 64 + fr + ai * HALF + m * 16; const int row = u.pm * BM + rl;
                const f32x4* sp = (const f32x4*)(ssq + (size_t)row * 16); const f32x4 a = sp[0], b = sp[1], c = sp[2], d = sp[3];
                const float t = ((a[0] + a[1]) + (a[2] + a[3])) + ((b[0] + b[1]) + (b[2] + b[3])) + ((c[0] + c[1]) + (c[2] + c[3])) + ((d[0] + d[1]) + (d[2] + d[3]));
                const float s = __builtin_amdgcn_rsqf(t * (1.0f / 1024.0f) + 1e-6f);
                float mx = -3.0e38f;
#pragma unroll
                for (int bj = 0; bj < 2; ++bj)
#pragma unroll
                    for (int n = 0; n < 2; ++n) { const f32x4 v = acc[ai][bj][m][n] * s; mx = fmaxf(mx, fmaxf(fmaxf(v[0], v[1]), fmaxf(v[2], v[3]))); }
                mx = xmax16(mx); mx = xmax32(mx);
                float l = 0.f;
#pragma unroll
                for (int bj = 0; bj < 2; ++bj)
#pragma unroll
                    for (int n = 0; n < 2; ++n) { const f32x4 v = acc[ai][bj][m][n] * s;
                        l += (__builtin_amdgcn_exp2f(v[0] - mx) + __builtin_amdgcn_exp2f(v[1] - mx)) + (__builtin_amdgcn_exp2f(v[2] - mx) + __builtin_amdgcn_exp2f(v[3] - mx)); }
                l = xadd16(l); l = xadd32(l);
                if (fq == 0) { ex[wc * 256 + rl] = mx; ex[1024 + wc * 256 + rl] = l; } }
        asm volatile("s_waitcnt lgkmcnt(0)" ::: "memory");
        __builtin_amdgcn_s_barrier();
#pragma unroll
        for (int ai = 0; ai < 2; ++ai)
#pragma unroll
            for (int m = 0; m < 4; ++m) { const int rl = wr * 64 + fr + ai * HALF + m * 16; const int row = u.pm * BM + rl;
                const float m0 = ex[rl], m1 = ex[256 + rl], m2 = ex[512 + rl], m3 = ex[768 + rl], l0 = ex[1024 + rl], l1 = ex[1280 + rl], l2 = ex[1536 + rl], l3 = ex[1792 + rl];
                const float M = fmaxf(fmaxf(m0, m1), fmaxf(m2, m3));
                const float L = (l0 * __builtin_amdgcn_exp2f(m0 - M) + l1 * __builtin_amdgcn_exp2f(m1 - M)) + (l2 * __builtin_amdgcn_exp2f(m2 - M) + l3 * __builtin_amdgcn_exp2f(m3 - M));
                const f32x4* sp = (const f32x4*)(ssq + (size_t)row * 16); const f32x4 a = sp[0], b = sp[1], c = sp[2], d = sp[3];
                const float t = ((a[0] + a[1]) + (a[2] + a[3])) + ((b[0] + b[1]) + (b[2] + b[3])) + ((c[0] + c[1]) + (c[2] + c[3])) + ((d[0] + d[1]) + (d[2] + d[3]));
                const float inv = __builtin_amdgcn_rcpf(L), s = __builtin_amdgcn_rsqf(t * (1.0f / 1024.0f) + 1e-6f);
                bf16_t* rowp = O + (size_t)row * ldc + u.pn * BM + wc * 32 + 8 * fq;
#pragma unroll
                for (int bj = 0; bj < 2; ++bj) { const f32x4 v0 = acc[ai][bj][m][0] * s, v1 = acc[ai][bj][m][1] * s; u32x4 w;
                    const float p0 = __builtin_amdgcn_exp2f(v0[0] - M) * inv, p1 = __builtin_amdgcn_exp2f(v0[1] - M) * inv, p2 = __builtin_amdgcn_exp2f(v0[2] - M) * inv, p3 = __builtin_amdgcn_exp2f(v0[3] - M) * inv;
                    const float p4 = __builtin_amdgcn_exp2f(v1[0] - M) * inv, p5 = __builtin_amdgcn_exp2f(v1[1] - M) * inv, p6 = __builtin_amdgcn_exp2f(v1[2] - M) * inv, p7 = __builtin_amdgcn_exp2f(v1[3] - M) * inv;
                    w.x = cvt_pk_bf16(p0, p1); w.y = cvt_pk_bf16(p2, p3); w.z = cvt_pk_bf16(p4, p5); w.w = cvt_pk_bf16(p6, p7);
                    *(u32x4*)(rowp + bj * HALF) = w; } }
        asm volatile("s_waitcnt lgkmcnt(0)" ::: "memory");
        __builtin_amdgcn_s_barrier();
    }
};
template <class Epi, class Sched, bool ALIGN_EPI = false, bool SP2 = false>
__device__ __forceinline__ void gemm_phase(PG8_LAS unsigned char* lds, const Gemm g, const Sched& S, const Epi& E) {
    int tid_ = threadIdx.x; asm volatile("" : "+v"(tid_));
    const int tid = tid_, wid = __builtin_amdgcn_readfirstlane(tid >> 6), lane = tid & 63, wr = wid >> 2, wc = wid & 3, fr = lane & 15, fq = lane >> 4;
    const int K = g.K, nt = K / BK;
    unsigned voffA[2], voffB[2];
#pragma unroll
    for (int i = 0; i < 2; ++i) { int R, C; stage_rc(tid * 16 + i * 8192, R, C); const int Rb = Epi::PERM ? ((R & ~31) + perm32(R & 31)) : R;
        voffA[i] = (unsigned)(R * K + C) * 2u; voffB[i] = (unsigned)(Rb * K + C) * 2u; }
    const size_t kstep = (size_t)(BK * 2);
    const size_t hstep = (size_t)HALF * K * 2;
    const size_t tstep = 2 * hstep;
    const unsigned ldsw = (unsigned)wid * 1024u;
    const int aoff = lds_byte(wr * 64 + fr, fq * 8), boff = lds_byte(wc * 32 + fr, fq * 8);
#define PG8_SA(b, h) (((b) * 2 + (h)) * HTB)
#define PG8_SB(b, h) ((4 + (b) * 2 + (h)) * HTB)
#define PG8_STAGE(bufoff, gbase, voff) do { _Pragma("unroll") for (int _i = 0; _i < 2; ++_i) \
        __builtin_amdgcn_global_load_lds((const unsigned*)((const char*)(gbase) + (voff)[_i]), (PG8_LAS unsigned*)(lds + (bufoff) + ldsw + _i * 8192), 16, 0, 0); } while (0)
#define PG8_LDA(dst, b, h) do { _Pragma("unroll") for (int m = 0; m < 4; ++m) _Pragma("unroll") for (int k = 0; k < 2; ++k) dst[m][k] = *(const PG8_LAS bf16x8*)(lds + PG8_SA(b, h) + aoff + m * 2048 + k * 1024); } while (0)
#define PG8_LDB(dst, b, h) do { _Pragma("unroll") for (int n = 0; n < 2; ++n) _Pragma("unroll") for (int k = 0; k < 2; ++k) dst[n][k] = *(const PG8_LAS bf16x8*)(lds + PG8_SB(b, h) + boff + n * 2048 + k * 1024); } while (0)
#define PG8_MMA(ai, bj, At, Bt) do { __builtin_amdgcn_s_setprio(1); _Pragma("unroll") for (int m = 0; m < 4; ++m) _Pragma("unroll") for (int n = 0; n < 2; ++n) _Pragma("unroll") for (int k = 0; k < 2; ++k) \
        acc[ai][bj][m][n] = __builtin_amdgcn_mfma_f32_16x16x32_bf16(Bt[n][k], At[m][k], acc[ai][bj][m][n], 0, 0, 0); __builtin_amdgcn_s_setprio(0); } while (0)
#define PG8_WAIT_V(n) asm volatile("s_waitcnt vmcnt(" #n ")" ::: "memory")
#define PG8_WAIT_L(n) asm volatile("s_waitcnt lgkmcnt(" #n ")" ::: "memory")
#define PG8_BAR __builtin_amdgcn_s_barrier()
#define PG8_SCHED __builtin_amdgcn_sched_barrier(0)
    Unit cur, nxt; int ui = 0;
    if (!S.next(0, cur)) return;
    f32x4 acc[2][2][4][2];
#pragma unroll
    for (int a = 0; a < 2; ++a)
#pragma unroll
        for (int b = 0; b < 2; ++b)
#pragma unroll
            for (int m = 0; m < 4; ++m)
#pragma unroll
                for (int n = 0; n < 2; ++n) acc[a][b][m][n] = (f32x4){0.f, 0.f, 0.f, 0.f};
    bf16x8 At[4][2], B0[2][2], B1[2][2];
    const char* cA = (const char*)g.A + (size_t)cur.pm * tstep; const char* cB = (const char*)g.Bt + (size_t)cur.pn * tstep + (size_t)(cur.pm >> g.bshift) * g.bstride;
    S.a_ready(cur);
    if constexpr (SP2) {
        PG8_STAGE(PG8_SB(0, 0), cB, voffB); PG8_STAGE(PG8_SB(0, 1), cB + hstep, voffB); PG8_STAGE(PG8_SA(0, 0), cA, voffA); PG8_STAGE(PG8_SA(0, 1), cA + hstep, voffA);
        if (wr == 1) PG8_BAR;
        PG8_WAIT_V(2); PG8_BAR;
        PG8_STAGE(PG8_SB(1, 0), cB + kstep, voffB); PG8_STAGE(PG8_SA(1, 0), cA + kstep, voffA); PG8_STAGE(PG8_SB(1, 1), cB + hstep + kstep, voffB);
        PG8_WAIT_V(6); PG8_BAR;
    } else {
        PG8_STAGE(PG8_SB(0, 0), cB, voffB); PG8_STAGE(PG8_SA(0, 0), cA, voffA); PG8_STAGE(PG8_SB(0, 1), cB + hstep, voffB); PG8_STAGE(PG8_SA(0, 1), cA + hstep, voffA);
        if (wr == 1) PG8_BAR;
        PG8_WAIT_V(4); PG8_BAR;
        PG8_STAGE(PG8_SB(1, 0), cB + kstep, voffB); PG8_STAGE(PG8_SA(1, 0), cA + kstep, voffA); PG8_STAGE(PG8_SB(1, 1), cB + hstep + kstep, voffB);
        PG8_WAIT_V(6); PG8_BAR;
    }
    for (;;) {
        const bool has_next = S.next(ui + 1, nxt);
        const char* nA = has_next ? (const char*)g.A + (size_t)nxt.pm * tstep : cA; const char* nB = has_next ? (const char*)g.Bt + (size_t)nxt.pn * tstep + (size_t)(nxt.pm >> g.bshift) * g.bstride : cB;
        for (int t = 0; t < nt; t += 2) {
            const bool last = (t == nt - 2);
            const char* a1 = cA + (size_t)(t + 1) * kstep;
            const char* a2 = last ? nA : cA + (size_t)(t + 2) * kstep; const char* b2 = last ? nB : cB + (size_t)(t + 2) * kstep;
            const char* a3 = a2 + kstep; const char* b3 = b2 + kstep;
            if (last && has_next) S.a_ready(nxt);
            if constexpr (SP2) {
            PG8_LDB(B0, 0, 0); PG8_LDB(B1, 0, 1); PG8_SCHED; PG8_LDA(At, 0, 0); PG8_STAGE(PG8_SA(1, 1), a1 + hstep, voffA);
            PG8_WAIT_V(8); PG8_WAIT_L(0); PG8_BAR; PG8_MMA(0, 0, At, B0); PG8_MMA(0, 1, At, B1); PG8_BAR; PG8_SCHED;
            PG8_LDA(At, 0, 1); PG8_STAGE(PG8_SB(0, 0), b2, voffB); PG8_STAGE(PG8_SB(0, 1), b2 + hstep, voffB); PG8_STAGE(PG8_SA(0, 0), a2, voffA);
            PG8_WAIT_V(8); PG8_WAIT_L(0); PG8_BAR; PG8_MMA(1, 0, At, B0); PG8_MMA(1, 1, At, B1); PG8_BAR; PG8_SCHED;
            PG8_LDB(B0, 1, 0); PG8_LDB(B1, 1, 1); PG8_SCHED; PG8_LDA(At, 1, 0); PG8_STAGE(PG8_SA(0, 1), a2 + hstep, voffA);
            PG8_WAIT_V(8); PG8_WAIT_L(0); PG8_BAR; PG8_MMA(0, 0, At, B0); PG8_MMA(0, 1, At, B1); PG8_BAR; PG8_SCHED;
            PG8_LDA(At, 1, 1); PG8_STAGE(PG8_SB(1, 0), b3, voffB); PG8_STAGE(PG8_SB(1, 1), b3 + hstep, voffB); PG8_STAGE(PG8_SA(1, 0), a3, voffA);
            PG8_WAIT_V(8); PG8_WAIT_L(0); PG8_BAR; PG8_MMA(1, 0, At, B0); PG8_MMA(1, 1, At, B1); PG8_BAR; PG8_SCHED;
            } else {
            PG8_LDB(B0, 0, 0); PG8_SCHED; PG8_LDA(At, 0, 0); PG8_STAGE(PG8_SA(1, 1), a1 + hstep, voffA);
            PG8_WAIT_L(8); PG8_BAR; PG8_WAIT_L(0); PG8_MMA(0, 0, At, B0); PG8_BAR; PG8_SCHED;
            PG8_LDB(B1, 0, 1); PG8_STAGE(PG8_SB(0, 0), b2, voffB);
            PG8_BAR; PG8_WAIT_L(0); PG8_MMA(0, 1, At, B1); PG8_BAR;
            PG8_LDA(At, 0, 1); PG8_STAGE(PG8_SA(0, 0), a2, voffA);
            PG8_BAR; PG8_WAIT_L(0); PG8_MMA(1, 0, At, B0); PG8_BAR; PG8_SCHED;
            PG8_STAGE(PG8_SB(0, 1), b2 + hstep, voffB);
            PG8_WAIT_V(6); PG8_BAR; PG8_MMA(1, 1, At, B1); PG8_BAR;
            PG8_LDB(B0, 1, 0); PG8_SCHED; PG8_LDA(At, 1, 0); PG8_STAGE(PG8_SA(0, 1), a2 + hstep, voffA);
            PG8_WAIT_L(8); PG8_BAR; PG8_WAIT_L(0); PG8_MMA(0, 0, At, B0); PG8_BAR; PG8_SCHED;
            PG8_LDB(B1, 1, 1); PG8_STAGE(PG8_SB(1, 0), b3, voffB);
            PG8_BAR; PG8_WAIT_L(0); PG8_MMA(0, 1, At, B1); PG8_BAR;
            PG8_LDA(At, 1, 1); PG8_STAGE(PG8_SA(1, 0), a3, voffA);
            PG8_BAR; PG8_WAIT_L(0); PG8_MMA(1, 0, At, B0); PG8_BAR; PG8_SCHED;
            PG8_STAGE(PG8_SB(1, 1), b3 + hstep, voffB);
            PG8_WAIT_V(6); PG8_BAR; PG8_MMA(1, 1, At, B1); PG8_BAR;
            }
        }
        if constexpr (ALIGN_EPI) { if (wr == 0) PG8_BAR; }
        if constexpr (!Epi::AFTER_DRAIN) { E(acc, cur, wr, wc, fr, fq); S.done(cur); }
        if (!has_next) break;
#pragma unroll
        for (int a = 0; a < 2; ++a)
#pragma unroll
            for (int b = 0; b < 2; ++b)
#pragma unroll
                for (int m = 0; m < 4; ++m)
#pragma unroll
                    for (int n = 0; n < 2; ++n) acc[a][b][m][n] = (f32x4){0.f, 0.f, 0.f, 0.f};
        cur = nxt; cA = nA; cB = nB; ++ui;
        if constexpr (ALIGN_EPI) { if (wr == 1) PG8_BAR; }
    }
    PG8_WAIT_V(0);
    if constexpr (!ALIGN_EPI) { if (wr == 0) PG8_BAR; }
    PG8_BAR;
    if constexpr (Epi::AFTER_DRAIN) { E.fused(acc, cur, wr, wc, fr, fq, lds, wid, lane); S.done(cur); }
#undef PG8_SA
#undef PG8_SB
#undef PG8_STAGE
#undef PG8_LDA
#undef PG8_LDB
#undef PG8_MMA
#undef PG8_WAIT_V
#undef PG8_WAIT_L
#undef PG8_BAR
#undef PG8_SCHED
}
}
#define GAS __attribute__((address_space(1)))
#define LAS __attribute__((address_space(3)))
typedef unsigned short bf16;
typedef unsigned v4u __attribute__((ext_vector_type(4)));
typedef float f32x4 __attribute__((ext_vector_type(4)));
typedef short bf16x8 __attribute__((ext_vector_type(8)));
typedef GAS unsigned gu32;
typedef GAS unsigned long long gu64;
#define RLX_AGENT __ATOMIC_RELAXED, __HIP_MEMORY_SCOPE_AGENT
#define LDS_WAIT() asm volatile("s_waitcnt lgkmcnt(0)" ::: "memory")
#define VM_WAIT() asm volatile("s_waitcnt vmcnt(0)" ::: "memory")
__device__ __forceinline__ unsigned long long rt() { return __builtin_amdgcn_s_memrealtime(); }
__device__ __forceinline__ unsigned f2bf(float f) { unsigned u = __builtin_bit_cast(unsigned, f); return (u + 0x7fffu + ((u >> 16) & 1u)) >> 16; }
__device__ __forceinline__ unsigned pk2(float lo, float hi) { return f2bf(lo) | (f2bf(hi) << 16); }
#define XB_TMO      128
#define XB_XCNT(j)  (256  + 64 * (j))
#define XB_XSUB(j)  (1280 + 64 * (j))
#define XB_XGEN(j)  (2304 + 64 * (j))
#define XB_TOP      3328
#define XB_TOPGEN   3392
#define XCD_BAR_WORDS 3456
#define XB_SPIN_CAP (1u << 18)

__device__ __forceinline__ unsigned xb_ld(unsigned* p)              { return __hip_atomic_load(p, __ATOMIC_RELAXED, __HIP_MEMORY_SCOPE_AGENT); }
__device__ __forceinline__ unsigned xb_add(unsigned* p, unsigned v) { return __hip_atomic_fetch_add(p, v, __ATOMIC_RELAXED, __HIP_MEMORY_SCOPE_AGENT); }
__device__ __forceinline__ unsigned xb_xcc_id() { return (unsigned)__builtin_amdgcn_s_getreg((3 << 11) | 20) & 0xFu; }
#define XB_SPIN(cond, bar) do { unsigned _sp = 0; while (cond) { __builtin_amdgcn_s_sleep(1); \
    if ((++_sp & 255u) == 0u) { if (xb_ld(&(bar)[XB_TMO])) break; if (_sp > XB_SPIN_CAP) { atomicAdd(&(bar)[XB_TMO], 1u); break; } } } } while (0)

struct XcdBarrier {
    unsigned* bar; unsigned x;
    volatile LAS unsigned* st;
};

__device__ __forceinline__ XcdBarrier xcd_barrier_post(unsigned* bar, volatile LAS unsigned* st) {
    XcdBarrier b; b.bar = bar; b.x = xb_xcc_id(); b.st = st;
    if (threadIdx.x == 0) (void)xb_add(&bar[XB_XCNT(b.x)], 1u);
    return b;
}
__device__ __forceinline__ void xcd_barrier_complete(unsigned* bar, unsigned x, unsigned& nloc, unsigned& nx) {
    const unsigned G = gridDim.x * gridDim.y * gridDim.z;
    unsigned sum, cnt, mine, sp = 0u;
    for (;;) {
        sum = 0u; cnt = 0u; mine = 0u;
#pragma unroll
        for (unsigned j = 0; j < 16; ++j) { const unsigned c = xb_ld(&bar[XB_XCNT(j)]); sum += c; cnt += (c > 0u) ? 1u : 0u; mine = (j == x) ? c : mine; }
        if (sum == G) break;
        __builtin_amdgcn_s_sleep(1);
        if ((++sp & 255u) == 0u) { if (xb_ld(&bar[XB_TMO])) break; if (sp > XB_SPIN_CAP) { atomicAdd(&bar[XB_TMO], 1u); break; } }
    }
    nloc = mine > 0u ? mine : 1u; nx = cnt > 0u ? cnt : 1u;
}

__device__ __forceinline__ void xcd_barrier(const XcdBarrier& b) {
    asm volatile("s_waitcnt vmcnt(0)" ::: "memory");
    __syncthreads();
    if (threadIdx.x == 0) {
        unsigned* bar = b.bar;
        __builtin_amdgcn_s_waitcnt(0);
        unsigned nloc = b.st[0], nx = b.st[1];
        if (nloc == 0u) { xcd_barrier_complete(bar, b.x, nloc, nx); b.st[0] = nloc; b.st[1] = nx; }
        const unsigned old = xb_add(&bar[XB_XSUB(b.x)], 1u);
        const unsigned gen = old / nloc;
        if (old + 1u == (gen + 1u) * nloc) {
            __builtin_amdgcn_fence(__ATOMIC_RELEASE, "agent");
            asm volatile("s_waitcnt vmcnt(0)" ::: "memory");
            const unsigned og = xb_add(&bar[XB_TOP], 1u);
            const unsigned tg = og / nx;
            if (og + 1u == (tg + 1u) * nx) xb_add(&bar[XB_TOPGEN], 1u);
            else XB_SPIN(xb_ld(&bar[XB_TOPGEN]) == tg, bar);
            __builtin_amdgcn_fence(__ATOMIC_ACQUIRE, "agent");
            xb_add(&bar[XB_XGEN(b.x)], 1u);
            asm volatile("s_waitcnt vmcnt(0)" ::: "memory");
        } else {
            XB_SPIN(xb_ld(&bar[XB_XGEN(b.x)]) == gen, bar);
            __builtin_amdgcn_fence(__ATOMIC_ACQUIRE, "agent");
            asm volatile("s_waitcnt vmcnt(0)" ::: "memory");
        }
    }
    __syncthreads();
}

typedef float f32x16 __attribute__((ext_vector_type(16)));
typedef short v4i16_t __attribute__((ext_vector_type(4)));
typedef float f32x2_t __attribute__((ext_vector_type(2)));
typedef __bf16 bf16x2_t __attribute__((ext_vector_type(2)));
#define DI __device__ __forceinline__
#define MFMA32(a, b, c) __builtin_amdgcn_mfma_f32_32x32x16_bf16((a), (b), (c), 0, 0, 0)
DI int crow(int r, int h) { return (r & 3) + 8 * (r >> 2) + 4 * h; }
DI unsigned cvtpk(float lo, float hi) { f32x2_t v = {lo, hi}; bf16x2_t b = __builtin_convertvector(v, bf16x2_t); return __builtin_bit_cast(unsigned, b); }
template <int S8> DI bf16x8 pack8(const f32x16& x) { v4u p; p.x = cvtpk(x[8 * S8], x[8 * S8 + 1]); p.y = cvtpk(x[8 * S8 + 2], x[8 * S8 + 3]); p.z = cvtpk(x[8 * S8 + 4], x[8 * S8 + 5]); p.w = cvtpk(x[8 * S8 + 6], x[8 * S8 + 7]); return __builtin_bit_cast(bf16x8, p); }
DI v4i16_t tr16(const LAS unsigned char* p) { return __builtin_amdgcn_ds_read_tr16_b64_v4i16((LAS v4i16_t*)p); }
DI bf16x8 tr_frag(const LAS unsigned char* p, int stride) { const v4i16_t lo = tr16(p), hi = tr16(p + 8 * stride); return (bf16x8){lo[0], lo[1], lo[2], lo[3], hi[0], hi[1], hi[2], hi[3]}; }
DI int tr_base(int lane, int stride) { const int i = lane & 15, g = lane >> 4; return (4 * (g >> 1) + (i >> 2)) * stride + (16 * (g & 1) + 4 * (i & 3)) * 2; }
DI bf16x8 tr_frag_nat(const LAS unsigned char* p, int stride) { const v4i16_t lo = tr16(p), hi = tr16(p + 4 * stride); return (bf16x8){lo[0], lo[1], lo[2], lo[3], hi[0], hi[1], hi[2], hi[3]}; }
DI int tr_base_nat(int lane, int stride) { const int i = lane & 15, g = lane >> 4; return (8 * (g >> 1) + (i >> 2)) * stride + (16 * (g & 1) + 4 * (i & 3)) * 2; }
template <int NCH> DI int swz_off(int r, int c) { return r * (NCH * 16) + ((c ^ (r & (NCH >= 16 ? 15 : 7))) << 4); }
#define DPP_U(x, ctrl) ((unsigned)__builtin_amdgcn_update_dpp(0, (int)(x), (ctrl), 0xf, 0xf, false))
#define DPP_F(x, ctrl) __builtin_bit_cast(float, __builtin_amdgcn_update_dpp(0, __builtin_bit_cast(int, (float)(x)), (ctrl), 0xf, 0xf, false))
__device__ __forceinline__ unsigned row_max_u(unsigned m) {
    m = max(m, DPP_U(m, 0xB1)); m = max(m, DPP_U(m, 0x4E)); m = max(m, DPP_U(m, 0x141)); m = max(m, DPP_U(m, 0x140)); return m;
}
__device__ __forceinline__ float row_sum_f(float s) {
    s += DPP_F(s, 0xB1); s += DPP_F(s, 0x4E); s += DPP_F(s, 0x141); s += DPP_F(s, 0x140); return s;
}
using pg8::xadd16; using pg8::xadd32; using pg8::xmax32;
__device__ __forceinline__ float wave_sum_dpp(float s) { s = row_sum_f(s); s = xadd16(s); s = xadd32(s); return s; }
__device__ __forceinline__ float bf_lo(unsigned w) { return __builtin_bit_cast(float, w << 16); }
__device__ __forceinline__ float bf_hi(unsigned w) { return __builtin_bit_cast(float, w & 0xFFFF0000u); }
constexpr int NWAVES = 8;
constexpr int T = 32768, D = 1024, SEQ = 4096, NBATCH = 8, PROJ_W = 3592, PROJ_N = 3584;
constexpr float EPS = 1e-6f, LOG2E = 1.4426950408889634f, LN2 = 0.6931471805599453f;
constexpr int PC_QM = 0, PC_KM = 512, PC_VM = 1024, PC_OM = 1536, PC_QS = 2048, PC_KS = 2560, PC_VS = 3072;
constexpr size_t MiB = 1u << 20;
constexpr size_t WS_CTL = 0, CTL_ZERO_BYTES = 1 * MiB;
constexpr size_t WS_SSQ0 = 1 * MiB, WS_GATES = 2 * MiB, WS_SSQ1 = 74 * MiB, WS_SSQ2 = 76 * MiB;
constexpr size_t WS_WIN = 4 * MiB, WS_WOUT = 11 * MiB, WS_WQ = 13 * MiB, WS_WKV = 15 * MiB, WS_WO = 19 * MiB, WS_WPS = 21 * MiB;
constexpr size_t WS_MEMN = 26 * MiB, WS_KVX = 30 * MiB;
constexpr size_t WS_M1 = 78 * MiB, WS_M2 = 460 * MiB;
constexpr size_t WS_UB = 40 * MiB, WS_USC = 72 * MiB;
constexpr size_t WS_XB = 104 * MiB;
constexpr size_t WS_MIX = 168 * MiB;
constexpr size_t WS_PROJ = 232 * MiB;
constexpr size_t WS_OX = 232 * MiB, WS_SC = 296 * MiB;
constexpr size_t WS_SCR = 456 * MiB, WS_END = 512 * MiB;
constexpr int CW_BAR = 4096;
constexpr int RING_BYTES = 131072, LDSCTL_OFF = 147456, MISC_OFF = LDSCTL_OFF + 320, LDS_BYTES = 151552;

typedef _Float16 h32 __attribute__((ext_vector_type(32)));
typedef float f32x32 __attribute__((ext_vector_type(32)));
typedef unsigned u32x6 __attribute__((ext_vector_type(6)));
typedef unsigned u32x2f __attribute__((ext_vector_type(2)));
struct Frame {
    LAS unsigned char* lds;
    volatile LAS unsigned* MISC;
    gu32* ctl;
    int tid, lane, wave, vcu, G;
    const float* in[22];
    float* out; unsigned char* ws;
};
enum { I_X = 0, I_MEM, I_MIXG, I_WIN, I_CONVW, I_CONVB, I_IGB, I_FGB, I_MNG, I_SNG, I_WOUT, I_XNG, I_MEMG, I_WQ, I_WKV, I_WO, I_FFNG, I_PWQ, I_PSK, I_PU, I_PV, I_FING };

__device__ __forceinline__ float wave_sum(float v) {
#pragma unroll
    for (int o = 1; o < 64; o <<= 1) v += __shfl_xor(v, o);
    return v;
}
__device__ __forceinline__ float log_sigmoid_f(float x) { return fminf(x, 0.f) - log1pf(expf(-fabsf(x))); }

template <bool BLK = false> __device__ __forceinline__ void p0_transpose_item(const float* W, int ldw, int K, int ncols, bf16* WT, int row_off, LAS float* scr, int item, int lane, const float* gk, float sc) {
    const int nblk = ncols / 32, kb = item / nblk, nb = item % nblk, k0 = 64 * kb, n0 = 32 * nb;
    const int r8 = lane >> 3, c4 = lane & 7;
    f32x4 w[8];
#pragma unroll
    for (int i = 0; i < 8; ++i) w[i] = *(const GAS f32x4*)(W + (size_t)(k0 + r8 + 8 * i) * ldw + n0 + 4 * c4);
#pragma unroll
    for (int i = 0; i < 8; ++i) { const int kk = r8 + 8 * i; const float g = (gk ? gk[k0 + kk] : 1.0f) * sc; LAS float* d = scr + kk * 33 + 4 * c4;
        d[0] = w[i].x * g; d[1] = w[i].y * g; d[2] = w[i].z * g; d[3] = w[i].w * g; }
    LDS_WAIT(); asm volatile("" ::: "memory");
    const int c = lane & 7;
#pragma unroll
    for (int j = 0; j < 4; ++j) { const int n = (lane >> 3) + 8 * j; const LAS float* s = scr + (8 * c) * 33 + n;
        v4u o; o.x = cvtpk(s[0 * 33], s[1 * 33]); o.y = cvtpk(s[2 * 33], s[3 * 33]); o.z = cvtpk(s[4 * 33], s[5 * 33]); o.w = cvtpk(s[6 * 33], s[7 * 33]);
        if (BLK) *(GAS v4u*)(WT + ((size_t)(k0 >> 8) * ncols + n0 + n) * 256 + (k0 & 255) + 8 * c) = o;
        else *(GAS v4u*)(WT + (size_t)(row_off + n0 + n) * K + k0 + 8 * c) = o; }
    LDS_WAIT(); asm volatile("" ::: "memory");
}

__device__ __forceinline__ void p0_tr_a(Frame& F) {
    const int gw = F.vcu * NWAVES + F.wave, NGW = F.G * NWAVES;
    unsigned char* ws = F.ws;
    {
        LAS float* scr = (LAS float*)(F.lds + F.wave * 16384);
        constexpr int I_IN0 = 16 * (2048 / 32), I_IN1 = 16 * (512 / 32), I_IN2 = 16 * (1024 / 32), I_SQ = 16 * 32, I_KV = 16 * 64;
        constexpr int NITEMS = I_IN0 + I_IN1 + I_IN2 + 3 * I_SQ + I_KV;
        const float* win = F.in[I_WIN]; const float* mg = F.in[I_MIXG];
        for (int it = gw; it < NITEMS; it += NGW) {
            int r = it;
            if (r < I_IN0) { p0_transpose_item(win, PROJ_W, D, 2048, (bf16*)(ws + WS_WIN), 0, scr, r, F.lane, mg, 1.0f); continue; } r -= I_IN0;
            if (r < I_IN1) { p0_transpose_item(win + 2056, PROJ_W, D, 512, (bf16*)(ws + WS_WIN), 2048, scr, r, F.lane, mg, 0.125f * LOG2E); continue; } r -= I_IN1;
            if (r < I_IN2) { p0_transpose_item(win + 2568, PROJ_W, D, 1024, (bf16*)(ws + WS_WIN), 2560, scr, r, F.lane, mg, 1.0f); continue; } r -= I_IN2;
            if (r < I_SQ) { p0_transpose_item(F.in[I_WOUT], D, D, D, (bf16*)(ws + WS_WOUT), 0, scr, r, F.lane, nullptr, 1.0f); continue; } r -= I_SQ;
            if (r < I_SQ) {
#pragma unroll
                for (int rr = 0; rr < 2; ++rr) { const int k = 2 * r + rr; const float gsc = F.in[I_XNG][k] * (0.0625f * LOG2E); const GAS f32x4* src = (const GAS f32x4*)(F.in[I_WQ] + (size_t)k * D) + F.lane;
                    f32x4 v[4];
#pragma unroll
                    for (int j = 0; j < 4; ++j) v[j] = src[64 * j];
#pragma unroll
                    for (int j = 0; j < 4; ++j) { u32x2f o; o.x = cvtpk(v[j].x * gsc, v[j].y * gsc); o.y = cvtpk(v[j].z * gsc, v[j].w * gsc);
                        *(GAS u32x2f*)((bf16*)(ws + WS_WQ) + ((size_t)j * 1024 + k) * 256 + 4 * F.lane) = o; } }
                continue; } r -= I_SQ;
            if (r < I_SQ) { p0_transpose_item<true>(F.in[I_WO], D, D, D, (bf16*)(ws + WS_WO), 0, scr, r, F.lane, nullptr, 1.0f); continue; } r -= I_SQ;
            p0_transpose_item(F.in[I_WKV], 2048, D, 2048, (bf16*)(ws + WS_WKV), 0, scr, r, F.lane, nullptr, 1.0f);
        }
    }
}
__device__ __forceinline__ void p0_split8(const f32x4 x0, const f32x4 x1, bf16x8& hi, bf16x8& lo) {
    v4u h, l;
    h.x = cvtpk(x0.x, x0.y); h.y = cvtpk(x0.z, x0.w); h.z = cvtpk(x1.x, x1.y); h.w = cvtpk(x1.z, x1.w);
    l.x = cvtpk(x0.x - bf_lo(h.x), x0.y - bf_hi(h.x)); l.y = cvtpk(x0.z - bf_lo(h.y), x0.w - bf_hi(h.y));
    l.z = cvtpk(x1.x - bf_lo(h.z), x1.y - bf_hi(h.z)); l.w = cvtpk(x1.z - bf_lo(h.w), x1.w - bf_hi(h.w));
    hi = __builtin_bit_cast(bf16x8, h); lo = __builtin_bit_cast(bf16x8, l);
}
__device__ __forceinline__ void p0_tr_b(Frame& F) {
    unsigned char* ws = F.ws;
    const float* pwq = F.in[I_PWQ]; const float* psk = F.in[I_PSK]; const float* fg = F.in[I_FFNG];
    bf16* WPS = (bf16*)(ws + WS_WPS);
    const int mt = F.wave & 3, nt = F.wave >> 2, r32 = F.lane & 31, g = F.lane >> 5;
    for (int it = F.vcu; it < 256; it += F.G) {
        const int hp = it >> 4, k0 = (it & 15) * 64;
        const int n = mt * 32 + r32, k = k0 + nt * 32 + r32;
        const GAS f32x4* ap = (const GAS f32x4*)(psk + ((size_t)hp * 128 + n) * 128 + 8 * g);
        const GAS f32x4* bp = (const GAS f32x4*)(pwq + (size_t)k * 2048 + hp * 128 + 8 * g);
        f32x4 av[16], bv[16];
#pragma unroll
        for (int s = 0; s < 8; ++s) { av[2 * s] = ap[4 * s]; av[2 * s + 1] = ap[4 * s + 1]; bv[2 * s] = bp[4 * s]; bv[2 * s + 1] = bp[4 * s + 1]; }
        const float gk = fg[k];
        f32x16 acc;
#pragma unroll
        for (int r = 0; r < 16; ++r) acc[r] = 0.f;
#pragma unroll
        for (int s = 0; s < 8; ++s) { bf16x8 ah, al, bh, bl; p0_split8(av[2 * s], av[2 * s + 1], ah, al); p0_split8(bv[2 * s] * gk, bv[2 * s + 1] * gk, bh, bl);
            acc = MFMA32(ah, bh, acc); acc = MFMA32(ah, bl, acc); acc = MFMA32(al, bh, acc); }
#pragma unroll
        for (int r = 0; r < 16; ++r) WPS[((size_t)hp * 128 + mt * 32 + crow(r, g)) * D + k0 + nt * 32 + r32] = (bf16)(cvtpk(acc[r], 0.f) & 0xFFFFu);
    }
}
__device__ __forceinline__ void p0_rows_d(Frame& F) {
    const int gw = F.vcu * NWAVES + F.wave, NGW = F.G * NWAVES;
    unsigned char* ws = F.ws;
    const GAS f32x4* xbase = (const GAS f32x4*)F.in[I_X] + F.lane;
    f32x4 vn[4];
#pragma unroll
    for (int j = 0; j < 4; ++j) vn[j] = xbase[(size_t)gw * 256 + 64 * j];
    LAS float* gwl = (LAS float*)F.lds;
    {
        f32x4 wv[4]; float mgv[4];
#pragma unroll
        for (int i = 0; i < 4; ++i) { const int id = F.tid + 512 * i, k = id >> 1, hf = id & 1; wv[i] = *(const GAS f32x4*)(F.in[I_WIN] + (size_t)k * PROJ_W + 2048 + 4 * hf); mgv[i] = F.in[I_MIXG][k]; }
#pragma unroll
        for (int i = 0; i < 4; ++i) { const int id = F.tid + 512 * i, k = id >> 1, hf = id & 1; LAS float* d = gwl + (4 * hf) * 1024 + k;
            d[0] = wv[i].x * mgv[i]; d[1024] = wv[i].y * mgv[i]; d[2048] = wv[i].z * mgv[i]; d[3072] = wv[i].w * mgv[i]; }
    }
    __syncthreads();
    {
        bf16* XB = (bf16*)(ws + WS_XB); float* ssq0 = (float*)(ws + WS_SSQ0); float* gates = (float*)(ws + WS_GATES);
        const float* igb = F.in[I_IGB]; const float* fgb = F.in[I_FGB];
        const int l15 = F.lane & 15;
        for (int m = gw; m < T; m += NGW) {
            f32x4 v[4];
#pragma unroll
            for (int j = 0; j < 4; ++j) v[j] = vn[j];
            const int mn = m + NGW;
            if (mn < T) {
#pragma unroll
                for (int j = 0; j < 4; ++j) vn[j] = xbase[(size_t)mn * 256 + 64 * j]; }
            float s = 0.f;
#pragma unroll
            for (int j = 0; j < 4; ++j) s += (v[j].x * v[j].x + v[j].y * v[j].y) + (v[j].z * v[j].z + v[j].w * v[j].w);
            GAS unsigned long long* o8 = (GAS unsigned long long*)(XB + (size_t)m * D) + F.lane;
#pragma unroll
            for (int j = 0; j < 4; ++j) o8[64 * j] = (unsigned long long)cvtpk(v[j].x, v[j].y) | ((unsigned long long)cvtpk(v[j].z, v[j].w) << 32);
            float t = row_sum_f(s);
#pragma unroll
            for (int g = 0; g < 8; ++g) { float d = 0.f;
#pragma unroll
                for (int j = 0; j < 4; ++j) { const f32x4 w = *(const LAS f32x4*)(gwl + g * 1024 + 4 * F.lane + 256 * j); d += (v[j].x * w.x + v[j].y * w.y) + (v[j].z * w.z + v[j].w * w.w); }
                d = row_sum_f(d); t = (l15 == g) ? d : t; }
            t = xadd16(t); t = xadd32(t);
            const float stot = __builtin_bit_cast(float, __builtin_amdgcn_readlane(__builtin_bit_cast(int, t), 8));
            const float r = rsqrtf(stot * (1.f / D) + EPS);
            if (F.lane == 8) ssq0[m] = t;
            if (F.lane < 8) { const int h = F.lane & 3; float pre = t * r; float val = (F.lane < 4) ? pre + igb[h] : log_sigmoid_f(pre + fgb[h]); gates[(size_t)m * 8 + F.lane] = val; }
        }
    }
}
__device__ __forceinline__ void p0_rows_e(Frame& F) {
    const int gw = F.vcu * NWAVES + F.wave, NGW = F.G * NWAVES;
    unsigned char* ws = F.ws;
    {
        bf16* MEMN = (bf16*)(ws + WS_MEMN); const float* g = F.in[I_MEMG];
        for (int m = gw; m < 2048; m += NGW) {
            const GAS f32x4* xr = (const GAS f32x4*)(F.in[I_MEM] + (size_t)m * D) + F.lane;
            f32x4 v[4]; float s = 0.f;
#pragma unroll
            for (int j = 0; j < 4; ++j) { v[j] = xr[64 * j]; s += (v[j].x * v[j].x + v[j].y * v[j].y) + (v[j].z * v[j].z + v[j].w * v[j].w); }
            s = wave_sum(s);
            const float r = rsqrtf(s * (1.f / D) + EPS);
            GAS unsigned long long* o8 = (GAS unsigned long long*)(MEMN + (size_t)m * D) + F.lane;
#pragma unroll
            for (int j = 0; j < 4; ++j) { const f32x4 gg = *((const GAS f32x4*)g + F.lane + 64 * j);
                o8[64 * j] = (unsigned long long)cvtpk(v[j].x * r * gg.x, v[j].y * r * gg.y) | ((unsigned long long)cvtpk(v[j].z * r * gg.z, v[j].w * r * gg.w) << 32); }
        }
    }
}
__device__ __forceinline__ void p0_rows_f(Frame& F) {
    const int gw = F.vcu * NWAVES + F.wave, NGW = F.G * NWAVES;
    unsigned char* ws = F.ws;
    {
        const size_t gt = (size_t)F.vcu * (NWAVES * 64) + F.tid, NT = (size_t)F.G * (NWAVES * 64);
        const GAS f32x4* pu_ = (const GAS f32x4*)F.in[I_PU] + F.lane; const GAS f32x4* pv_ = (const GAS f32x4*)F.in[I_PV] + F.lane;
        f32x4 un[4], wn[4];
        if (gw < 16384) {
#pragma unroll
            for (int j = 0; j < 4; ++j) { un[j] = pu_[(size_t)gw * 256 + 64 * j]; wn[j] = pv_[(size_t)gw * 256 + 64 * j]; } }
        for (int e = gw; e < 16384; e += NGW) {
            f32x4 u4[4], v4[4]; float mu = 0.f, mv = 0.f;
#pragma unroll
            for (int j = 0; j < 4; ++j) { u4[j] = un[j]; v4[j] = wn[j]; }
            const int en = e + NGW;
            if (en < 16384) {
#pragma unroll
                for (int j = 0; j < 4; ++j) { un[j] = pu_[(size_t)en * 256 + 64 * j]; wn[j] = pv_[(size_t)en * 256 + 64 * j]; } }
#pragma unroll
            for (int j = 0; j < 4; ++j) {
                mu = fmaxf(mu, fmaxf(fmaxf(fabsf(u4[j].x), fabsf(u4[j].y)), fmaxf(fabsf(u4[j].z), fabsf(u4[j].w))));
                mv = fmaxf(mv, fmaxf(fmaxf(fabsf(v4[j].x), fabsf(v4[j].y)), fmaxf(fabsf(v4[j].z), fabsf(v4[j].w)))); }
            { unsigned a_ = row_max_u(__builtin_bit_cast(unsigned, mu)), b_ = row_max_u(__builtin_bit_cast(unsigned, mv));
              a_ = max(a_, (unsigned)__shfl_xor((int)a_, 16)); b_ = max(b_, (unsigned)__shfl_xor((int)b_, 16));
              a_ = max(a_, (unsigned)__shfl_xor((int)a_, 32)); b_ = max(b_, (unsigned)__shfl_xor((int)b_, 32));
              mu = __builtin_bit_cast(float, a_); mv = __builtin_bit_cast(float, b_); }
            const float scu = (mu > 0.f) ? mu * (1.0f / 7.0f) : 1.0f, scv = (mv > 0.f) ? mv * (1.0f / 7.0f) : 1.0f, iu = 1.0f / scu, iv = 1.0f / scv;
            h32 hx;
#pragma unroll
            for (int j = 0; j < 4; ++j) { hx[4 * j] = (_Float16)(u4[j].x * iu); hx[4 * j + 1] = (_Float16)(u4[j].y * iu); hx[4 * j + 2] = (_Float16)(u4[j].z * iu); hx[4 * j + 3] = (_Float16)(u4[j].w * iu);
                hx[16 + 4 * j] = (_Float16)(v4[j].x * iv); hx[16 + 4 * j + 1] = (_Float16)(v4[j].y * iv); hx[16 + 4 * j + 2] = (_Float16)(v4[j].z * iv); hx[16 + 4 * j + 3] = (_Float16)(v4[j].w * iv); }
            const u32x6 p = __builtin_amdgcn_cvt_scalef32_pk32_fp6_f16(hx, 1.0f);
            unsigned char* dst = ws + WS_UB + (size_t)e * 1536;
            *(GAS v4u*)(dst + F.lane * 16) = (v4u){p[0], p[1], p[2], p[3]}; *(GAS u32x2f*)(dst + 1024 + F.lane * 8) = (u32x2f){p[4], p[5]};
            if (F.lane == 0) { ((float*)(ws + WS_USC))[2 * e] = scu; ((float*)(ws + WS_USC))[2 * e + 1] = scv; }
        }
    }
}
#ifndef REPEAT
#define REPEAT -1
#endif
#define P0_REP(k, call) call; if (REPEAT == (k)) { __syncthreads(); call; }
__device__ __forceinline__ void p0_prologue(Frame& F) {
    P0_REP(30, p0_tr_a(F))
    P0_REP(31, p0_tr_b(F))
    __syncthreads();
    P0_REP(32, p0_rows_d(F))
    P0_REP(33, p0_rows_e(F))
    P0_REP(34, p0_rows_f(F))
}
constexpr int ML_Q = 0, ML_K = 32768, ML_C = 65536, ML_V = 98304, ML_VST = 320, ML_SM = ML_V + 128 * ML_VST;
constexpr int SM_A2 = 0, SM_M2 = 512, SM_EMT = 1024, SM_INTER = 1536, SM_WS = 2048, SM_NB = 3072, SM_SSQ = 3328, SM_SCAL = 4352;
constexpr size_t MLG_CLOC = 0, MLG_CST = 64 * MiB;
constexpr size_t MLG_NLOC = WS_SCR, MLG_NST = WS_SCR + 524288, MLG_SCAL = WS_SCR + 1048576, MLG_MST = MLG_SCAL + 8192;
typedef unsigned u32x2g __attribute__((ext_vector_type(2)));
template <bool IS_MAX> __device__ __forceinline__ float wave_scan_incl(float x, int lane) {
#pragma unroll
    for (int off = 1; off < 64; off <<= 1) { const float y = __shfl_up(x, off); if (lane >= off) x = IS_MAX ? fmaxf(x, y) : x + y; }
    return x;
}
__device__ __forceinline__ float silu_f(float a) { return a / (1.0f + __expf(-a)); }
__device__ __forceinline__ void ml_conv_load(const bf16* PROJ, size_t rowbase, int c, int h, int which, int tg, int cc, v4u (&raw)[7]) {
    const int pc = which ? PC_KM : PC_QM;
#pragma unroll
    for (int i = 0; i < 7; ++i) { const int tl = c * 128 + 4 * tg - 3 + i;
        raw[i] = (v4u){0u, 0u, 0u, 0u};
        if (tl >= 0) raw[i] = *(const GAS v4u*)(PROJ + (rowbase + tl) * PROJ_N + pc + h * 128 + 8 * cc); }
}
__device__ __forceinline__ void ml_conv_apply(Frame& F, int h, int which, int tg, int cc, const v4u (&raw)[7], LAS unsigned char* dstl) {
    const int ch0 = (which ? 512 : 0) + h * 128 + 8 * cc;
    const float osc = which ? 0.08838834764831845f : 1.0f;
    float cw[4][8], cb[8];
#pragma unroll
    for (int j = 0; j < 4; ++j) { const f32x4 w0 = *(const f32x4*)(F.in[I_CONVW] + j * 1024 + ch0), w1 = *(const f32x4*)(F.in[I_CONVW] + j * 1024 + ch0 + 4);
        cw[j][0] = w0.x; cw[j][1] = w0.y; cw[j][2] = w0.z; cw[j][3] = w0.w; cw[j][4] = w1.x; cw[j][5] = w1.y; cw[j][6] = w1.z; cw[j][7] = w1.w; }
    { const f32x4 b0 = *(const f32x4*)(F.in[I_CONVB] + ch0), b1 = *(const f32x4*)(F.in[I_CONVB] + ch0 + 4);
      cb[0] = b0.x; cb[1] = b0.y; cb[2] = b0.z; cb[3] = b0.w; cb[4] = b1.x; cb[5] = b1.y; cb[6] = b1.z; cb[7] = b1.w; }
#pragma unroll
    for (int tt = 0; tt < 4; ++tt) { float o[8];
#pragma unroll
        for (int e = 0; e < 8; ++e) { float a = cb[e];
#pragma unroll
            for (int j = 0; j < 4; ++j) a += cw[j][e] * ((e & 1) ? bf_hi(raw[tt + j][e >> 1]) : bf_lo(raw[tt + j][e >> 1]));
            o[e] = silu_f(a) * osc; }
        v4u pk; pk.x = pk2(o[0], o[1]); pk.y = pk2(o[2], o[3]); pk.z = pk2(o[4], o[5]); pk.w = pk2(o[6], o[7]);
        *(LAS v4u*)(dstl + swz_off<16>(4 * tg + tt, cc)) = pk; }
    asm volatile("" ::: "memory");
}
__device__ __forceinline__ void ml_passA(Frame& F) {
    const int lane = F.lane, w = F.wave, tid = F.tid, tb = w >> 1, vh = w & 1;
    unsigned char* ws = F.ws;
    const bf16* PROJ = (const bf16*)(ws + WS_PROJ); const float* GATES = (const float*)(ws + WS_GATES);
    LAS unsigned char* Kl = F.lds + ML_K; LAS unsigned char* Vl = F.lds + ML_V; LAS unsigned char* SM = F.lds + ML_SM;
    LAS float* wsc = (LAS float*)(SM + SM_WS);
    float* CLOC = (float*)((unsigned char*)F.out + MLG_CLOC); float* NLOC = (float*)(ws + MLG_NLOC); float* SCAL = (float*)(ws + MLG_SCAL);
#pragma unroll 1
    for (int u = F.vcu; u < 1024; u += F.G) {
        const int bh = u >> 5, c = u & 31, b = bh >> 2, h = bh & 3;
        const size_t rowbase = (size_t)b * SEQ, t0 = rowbase + (size_t)c * 128;
        int hx = lane >> 5, qx = lane & 31, tx = tid; asm volatile("" : "+v"(hx), "+v"(qx), "+v"(tx));
        const int tg = tx >> 4, cc = tx & 15;
        const int trbn = tr_base_nat(hx * 32 + qx, ML_VST);
        v4u rk[7], vv[4]; float i0 = 0.f, i1 = 0.f, f0 = 0.f, f1 = 0.f;
        ml_conv_load(PROJ, rowbase, c, h, 1, tg, cc, rk);
#pragma unroll
        for (int i = 0; i < 4; ++i) { const int id = tx + 512 * i, row = id >> 4, c16 = id & 15; vv[i] = *(const GAS v4u*)(PROJ + (t0 + row) * PROJ_N + PC_VM + h * 128 + 8 * c16); }
        if (w == 0) { const float* gp = GATES + (t0 + 2 * lane) * 8; i0 = gp[h]; i1 = gp[8 + h]; f0 = gp[4 + h]; f1 = gp[12 + h]; }
        __syncthreads();
        ml_conv_apply(F, h, 1, tg, cc, rk, Kl);
#pragma unroll
        for (int i = 0; i < 4; ++i) { const int id = tx + 512 * i, row = id >> 4, c16 = id & 15; *(LAS v4u*)(Vl + row * ML_VST + c16 * 16) = vv[i]; }
        if (w == 0) {
            const float incl = wave_scan_incl<false>(f0 + f1, lane);
            float excl = __shfl_up(incl, 1); if (lane == 0) excl = 0.f;
            const float b0 = excl + f0, b1 = incl, a0 = i0 - b0, a1 = i1 - b1;
            float mloc = fmaxf(a0, a1);
#pragma unroll
            for (int o = 1; o < 64; o <<= 1) mloc = fmaxf(mloc, __shfl_xor(mloc, o));
            const float bL = __shfl(b1, 63);
            wsc[2 * lane] = __expf(a0 - mloc); wsc[2 * lane + 1] = __expf(a1 - mloc);
            if (lane == 0) { SCAL[2 * u] = bL; SCAL[2 * u + 1] = mloc; }
        }
        __syncthreads();
#pragma unroll
        for (int tt = 0; tt < 4; ++tt) { const int s = 4 * tg + tt; const float wv = wsc[s]; LAS v4u* kp = (LAS v4u*)(Kl + swz_off<16>(s, cc)); const v4u raw = *kp; v4u o;
            o.x = pk2(bf_lo(raw.x) * wv, bf_hi(raw.x) * wv); o.y = pk2(bf_lo(raw.y) * wv, bf_hi(raw.y) * wv); o.z = pk2(bf_lo(raw.z) * wv, bf_hi(raw.z) * wv); o.w = pk2(bf_lo(raw.w) * wv, bf_hi(raw.w) * wv);
            *kp = o; }
        __syncthreads();
        f32x16 cacc[2];
#pragma unroll
        for (int r = 0; r < 16; ++r) { cacc[0][r] = 0.f; cacc[1][r] = 0.f; }
        { const int i16 = qx & 15, g4 = 2 * hx + (qx >> 4);
#pragma unroll
          for (int ks = 0; ks < 8; ++ks) {
              const bf16x8 av = tr_frag_nat(Vl + trbn + (16 * ks) * ML_VST + (32 * tb) * 2, ML_VST);
#pragma unroll
              for (int kb2 = 0; kb2 < 2; ++kb2) { const int kcol = 32 * (2 * vh + kb2) + 16 * (g4 & 1) + 4 * (i16 & 3); const int srow = 16 * ks + 8 * hx + (i16 >> 2);
                  const v4i16_t lo = tr16(Kl + swz_off<16>(srow, kcol >> 3) + (kcol & 7) * 2), hi = tr16(Kl + swz_off<16>(srow + 4, kcol >> 3) + (kcol & 7) * 2);
                  const bf16x8 bk = (bf16x8){lo[0], lo[1], lo[2], lo[3], hi[0], hi[1], hi[2], hi[3]};
                  cacc[kb2] = MFMA32(av, bk, cacc[kb2]); } } }
        { float* cb = CLOC + (size_t)u * 16384;
#pragma unroll
          for (int kb2 = 0; kb2 < 2; ++kb2)
#pragma unroll
            for (int r = 0; r < 16; ++r) cb[(unsigned)(32 * tb + crow(r, hx)) * 128 + 32 * (2 * vh + kb2) + qx] = cacc[kb2][r]; }
        if (tx < 128) { const int k = tx; float a = 0.f;
            for (int s = 0; s < 128; ++s) a += bf_lo((unsigned)*(const LAS unsigned short*)(Kl + swz_off<16>(s, k >> 3) + (k & 7) * 2));
            NLOC[(size_t)u * 128 + k] = a; }
    }
    __syncthreads();
}
__device__ __forceinline__ void ml_passB(Frame& F) {
    const int tid = F.tid;
    unsigned char* ws = F.ws;
    const float* CLOC = (const float*)((unsigned char*)F.out + MLG_CLOC); unsigned char* CST = (unsigned char*)F.out + MLG_CST;
    const float* NLOC = (const float*)(ws + MLG_NLOC); float* NST = (float*)(ws + MLG_NST); const float* SCAL = (const float*)(ws + MLG_SCAL); float* MST = (float*)(ws + MLG_MST);
    LAS float* al = (LAS float*)F.lds; LAS float* be = al + 32;
#pragma unroll 1
    for (int it = F.vcu; it < 256; it += F.G) {
        const int bh = it >> 3, sl = it & 7;
        __syncthreads();
        if (tid < 64) {
            const int lc = tid & 31; const float fmx = SCAL[2 * (bh * 32 + lc)], fmy = SCAL[2 * (bh * 32 + lc) + 1];
            float m = 0.f, a_mine = 0.f, b_mine = 0.f, m_mine = 0.f;
#pragma unroll 1
            for (int c = 0; c < 32; ++c) { const float Fc = __builtin_bit_cast(float, __builtin_amdgcn_readlane(__builtin_bit_cast(int, fmx), c)), Ml = __builtin_bit_cast(float, __builtin_amdgcn_readlane(__builtin_bit_cast(int, fmy), c));
                const float Mx = fmaxf(m, Ml), a = __expf(m - Mx), b = __expf(Ml - Mx);
                if (tid == c) { a_mine = a; b_mine = b; m_mine = m; }
                m = Fc + Mx; }
            if (tid < 32) { al[tid] = a_mine; be[tid] = b_mine; if (sl == 0) MST[bh * 32 + tid] = m_mine; } }
        __syncthreads();
        const int g4 = sl * 512 + tid, v = g4 >> 5, kq = g4 & 31;
        const unsigned dsto = (unsigned)(swz_off<16>(v, kq >> 1) + (kq & 1) * 8);
        f32x4 st = (f32x4){0.f, 0.f, 0.f, 0.f};
#pragma unroll 1
        for (int c0 = 0; c0 < 32; c0 += 8) {
            f32x4 cl[8];
#pragma unroll
            for (int j = 0; j < 8; ++j) cl[j] = *(const GAS f32x4*)(CLOC + (size_t)(bh * 32 + c0 + j) * 16384 + (size_t)g4 * 4);
#pragma unroll
            for (int j = 0; j < 8; ++j) { const int c = c0 + j;
                u32x2g o; o.x = pk2(st.x, st.y); o.y = pk2(st.z, st.w);
                *(GAS u32x2g*)(CST + (size_t)(bh * 32 + c) * 32768 + dsto) = o;
                const float a = al[c], bb = be[c]; st = st * a + cl[j] * bb; }
        }
        if (sl == 0 && tid < 128) { float n = 0.f;
            for (int c = 0; c < 32; ++c) { NST[(size_t)(bh * 32 + c) * 128 + tid] = n; n = al[c] * n + be[c] * NLOC[(size_t)(bh * 32 + c) * 128 + tid]; } }
    }
    __syncthreads();
}
__device__ __forceinline__ void ml_passC(Frame& F) {
    const int lane = F.lane, w = F.wave, tid = F.tid, tb = w >> 1, vh = w & 1;
    unsigned char* ws = F.ws;
    const bf16* PROJ = (const bf16*)(ws + WS_PROJ); bf16* MIXED = (bf16*)(ws + WS_MIX); const float* GATES = (const float*)(ws + WS_GATES);
    const unsigned char* CST = (const unsigned char*)F.out + MLG_CST; const float* NST = (const float*)(ws + MLG_NST); const float* MST = (const float*)(ws + MLG_MST);
    LAS unsigned char* Ql = F.lds + ML_Q; LAS unsigned char* Kl = F.lds + ML_K; LAS unsigned char* Cl = F.lds + ML_C; LAS unsigned char* Vl = F.lds + ML_V;
    LAS unsigned char* SM = F.lds + ML_SM;
    LAS float* a2 = (LAS float*)(SM + SM_A2); LAS float* M2 = (LAS float*)(SM + SM_M2); LAS float* emt = (LAS float*)(SM + SM_EMT); LAS float* inter = (LAS float*)(SM + SM_INTER);
    LAS unsigned short* nb = (LAS unsigned short*)(SM + SM_NB); LAS float* ssqp = (LAS float*)(SM + SM_SSQ);
    const bf16x8 ones = (bf16x8){0x3F80, 0x3F80, 0x3F80, 0x3F80, 0x3F80, 0x3F80, 0x3F80, 0x3F80};
#pragma unroll 1
    for (int u = F.vcu; u < 1024; u += F.G) {
        const int bh = u >> 5, c = u & 31, b = bh >> 2, h = bh & 3;
        const size_t rowbase = (size_t)b * SEQ, t0 = rowbase + (size_t)c * 128;
        int hx = lane >> 5, qx = lane & 31, tx = tid; asm volatile("" : "+v"(hx), "+v"(qx), "+v"(tx));
        const int tg = tx >> 4, cc = tx & 15;
        const int trb = tr_base(hx * 32 + qx, ML_VST);
        v4u rq[7], rk[7], vv[4], cv[4]; float nstv = 0.f, m_run = 0.f, i0 = 0.f, i1 = 0.f, f0 = 0.f, f1 = 0.f;
        ml_conv_load(PROJ, rowbase, c, h, 0, tg, cc, rq);
        ml_conv_load(PROJ, rowbase, c, h, 1, tg, cc, rk);
#pragma unroll
        for (int i = 0; i < 4; ++i) { const int id = tx + 512 * i, row = id >> 4, c16 = id & 15;
            vv[i] = *(const GAS v4u*)(PROJ + (t0 + row) * PROJ_N + PC_VM + h * 128 + 8 * c16);
            cv[i] = *(const GAS v4u*)(CST + (size_t)u * 32768 + (size_t)id * 16); }
        if (tx < 128) nstv = NST[(size_t)u * 128 + tx];
        if (w == 0) { m_run = MST[u]; const float* gp = GATES + (t0 + 2 * lane) * 8; i0 = gp[h]; i1 = gp[8 + h]; f0 = gp[4 + h]; f1 = gp[12 + h]; }
        __syncthreads();
        ml_conv_apply(F, h, 0, tg, cc, rq, Ql);
        ml_conv_apply(F, h, 1, tg, cc, rk, Kl);
#pragma unroll
        for (int i = 0; i < 4; ++i) { const int id = tx + 512 * i, row = id >> 4, c16 = id & 15;
            *(LAS v4u*)(Vl + row * ML_VST + c16 * 16) = vv[i];
            *(LAS v4u*)(Cl + id * 16) = cv[i]; }
        if (tx < 128) nb[tx] = (unsigned short)f2bf(nstv);
        if (w == 0) {
            const float incl = wave_scan_incl<false>(f0 + f1, lane);
            float excl = __shfl_up(incl, 1); if (lane == 0) excl = 0.f;
            const float b0 = excl + f0, b1 = incl;
            const float a0 = i0 - b0, a1 = i1 - b1;
            const float inclm = wave_scan_incl<true>(fmaxf(a0, a1), lane);
            float exclm = __shfl_up(inclm, 1); if (lane == 0) exclm = -INFINITY;
            const float M0 = fmaxf(m_run, fmaxf(exclm, a0)), M1 = fmaxf(m_run, inclm);
            a2[2 * lane] = a0 * LOG2E; a2[2 * lane + 1] = a1 * LOG2E; M2[2 * lane] = M0 * LOG2E; M2[2 * lane + 1] = M1 * LOG2E;
            inter[2 * lane] = __expf(m_run - M0); inter[2 * lane + 1] = __expf(m_run - M1);
            emt[2 * lane] = __expf(-(b0 + M0)); emt[2 * lane + 1] = __expf(-(b1 + M1));
        }
        __syncthreads();
        unsigned og[16];
        { const bf16* ogb = PROJ + t0 * PROJ_N; const unsigned ogo = (unsigned)(32 * tb) * PROJ_N + PC_OM + h * 128 + 64 * vh + qx;
#pragma unroll
          for (int r = 0; r < 16; ++r) { const unsigned oo = ogo + (unsigned)crow(r, hx) * PROJ_N; og[r] = (unsigned)ogb[oo] | ((unsigned)ogb[oo + 32] << 16); } }
        f32x16 hn0, hn1, dn;
#pragma unroll
        for (int r = 0; r < 16; ++r) { hn0[r] = 0.f; hn1[r] = 0.f; dn[r] = 0.f; }
        bf16x8 qa[8];
#pragma unroll
        for (int ks = 0; ks < 8; ++ks) qa[ks] = *(const LAS bf16x8*)(Ql + swz_off<16>(32 * tb + qx, 2 * ks + hx));
#pragma unroll
        for (int ks = 0; ks < 8; ++ks) {
            hn0 = MFMA32(qa[ks], *(const LAS bf16x8*)(Cl + swz_off<16>(32 * (2 * vh) + qx, 2 * ks + hx)), hn0);
            hn1 = MFMA32(qa[ks], *(const LAS bf16x8*)(Cl + swz_off<16>(32 * (2 * vh + 1) + qx, 2 * ks + hx)), hn1);
            dn = MFMA32(qa[ks], *(const LAS bf16x8*)((LAS unsigned char*)nb + (16 * ks + 8 * hx) * 2), dn);
        }
#pragma unroll
        for (int r = 0; r < 16; ++r) { const float it = inter[32 * tb + crow(r, hx)]; hn0[r] *= it; hn1[r] *= it; dn[r] *= it; }
        const float M2t = M2[32 * tb + qx];
#pragma unroll 1
        for (int sb = 0; sb <= tb; ++sb) {
            f32x16 st;
#pragma unroll
            for (int r = 0; r < 16; ++r) st[r] = 0.f;
#pragma unroll
            for (int ks = 0; ks < 8; ++ks) st = MFMA32(*(const LAS bf16x8*)(Kl + swz_off<16>(32 * sb + qx, 2 * ks + hx)), qa[ks], st);
            const bool diag = (sb == tb);
#pragma unroll
            for (int r = 0; r < 16; ++r) { float p = st[r] * __builtin_amdgcn_exp2f(a2[32 * sb + crow(r, hx)] - M2t);
                if (diag) p = (crow(r, hx) <= qx) ? p : 0.f;
                st[r] = p; }
            const bf16x8 pa0 = pack8<0>(st), pa1 = pack8<1>(st);
            const LAS unsigned char* vb = Vl + trb + (32 * sb) * ML_VST + (64 * vh) * 2;
            hn0 = MFMA32(pa0, tr_frag(vb, ML_VST), hn0);
            hn1 = MFMA32(pa0, tr_frag(vb + 64, ML_VST), hn1);
            dn = MFMA32(pa0, ones, dn);
            hn0 = MFMA32(pa1, tr_frag(vb + 16 * ML_VST, ML_VST), hn0);
            hn1 = MFMA32(pa1, tr_frag(vb + 16 * ML_VST + 64, ML_VST), hn1);
            dn = MFMA32(pa1, ones, dn);
        }
        asm volatile("" ::: "memory");
        {
#pragma unroll
          for (int r = 0; r < 16; ++r) { const int rl = crow(r, hx); const int trow = 32 * tb + rl;
            const float dv = 1.0f / fmaxf(fabsf(dn[r]), emt[trow]);
            const float g0 = bf_lo(og[r]), g1 = bf_hi(og[r]);
            hn0[r] = hn0[r] * dv / (1.0f + __expf(-g0)); hn1[r] = hn1[r] * dv / (1.0f + __expf(-g1));
            float v = hn0[r] * hn0[r] + hn1[r] * hn1[r]; v = row_sum_f(v); v = xadd16(v);
            if (qx == 0) ssqp[w * 32 + rl] = v; } }
        __syncthreads();
        { const float* g = F.in[I_MNG] + h * 128 + 64 * vh; const float gg0 = g[qx], gg1 = g[32 + qx];
          bf16* opb = MIXED + t0 * D; const unsigned opo = (unsigned)(32 * tb) * D + h * 128 + 64 * vh + qx;
#pragma unroll
          for (int r = 0; r < 16; ++r) { const int rr = crow(r, hx); const float tot = ssqp[w * 32 + rr] + ssqp[(w ^ 1) * 32 + rr];
              const float rs = rsqrtf(tot * (1.0f / 128.0f) + EPS);
              const unsigned oo = opo + (unsigned)rr * D;
              opb[oo] = (bf16)f2bf(hn0[r] * rs * gg0); opb[oo + 32] = (bf16)f2bf(hn1[r] * rs * gg1); } }
    }
    __syncthreads();
}
constexpr int CW_SBQ = 8192; constexpr float SB_CUT = 64.0f;
constexpr int SB_KB = 8192, SB_VST = 192, SB_VB = 64 * SB_VST, SB_BUF = SB_KB + SB_VB;
__device__ __forceinline__ void sb_unit(Frame& F, int b, int h, int qt) {
    const int lane = F.lane, w = F.wave, tid = F.tid;
    int q32 = lane & 31, hh = lane >> 5; asm volatile("" : "+v"(q32), "+v"(hh));
    unsigned char* ws = F.ws;
    const bf16* PROJ = (const bf16*)(ws + WS_PROJ); bf16* MIXED = (bf16*)(ws + WS_MIX);
    const size_t rowbase = (size_t)b * SEQ;
    const int Q0 = qt * 256, qmin = Q0 + 32 * w, qmax = qmin + 31, query = qmin + q32;
    bf16x8 qf[4];
    { const bf16* qp = PROJ + (rowbase + query) * PROJ_N + PC_QS + h * 64 + 8 * hh;
#pragma unroll
      for (int ks = 0; ks < 4; ++ks) qf[ks] = *(const bf16x8*)(qp + 16 * ks); }
    f32x16 o0, o1;
#pragma unroll
    for (int r = 0; r < 16; ++r) { o0[r] = 0.f; o1[r] = 0.f; }
    float carry = 0.f;
    const int srow = tid >> 3, sc = tid & 7;
    const bf16* ksrc = PROJ + (rowbase + srow) * PROJ_N + PC_KS + h * 64 + sc * 8;
    const bf16* vsrc = PROJ + (rowbase + srow) * PROJ_N + PC_VS + h * 64 + sc * 8;
    const int kdst = swz_off<8>(srow, sc), vdst = SB_KB + srow * SB_VST + sc * 16;
    const int trb = tr_base(lane, SB_VST);
    const int jt_max = Q0 / 64 + 3;
    __syncthreads();
    { const v4u kv = *(const GAS v4u*)(ksrc + (size_t)jt_max * 64 * PROJ_N), vv = *(const GAS v4u*)(vsrc + (size_t)jt_max * 64 * PROJ_N);
      *(LAS v4u*)(F.lds + kdst) = kv; *(LAS v4u*)(F.lds + vdst) = vv; }
    __syncthreads();
    int cur = 0;
    volatile LAS unsigned* dflag = F.MISC + 32;
#pragma unroll 1
    for (int jt = jt_max; jt >= 0; --jt) {
        const bool done_w = __all(carry < -SB_CUT) != 0;
        v4u kn, vn;
        if (jt > 0) { kn = *(const GAS v4u*)(ksrc + (size_t)(jt - 1) * 64 * PROJ_N); vn = *(const GAS v4u*)(vsrc + (size_t)(jt - 1) * 64 * PROJ_N); }
        const LAS unsigned char* Kl = F.lds + cur * SB_BUF; const LAS unsigned char* Vl = Kl + SB_KB;
#pragma unroll
        for (int s = 1; s >= 0; --s) {
            const int kbase = 64 * jt + 32 * s;
            if (kbase < qmax && !done_w) {
                f32x16 acc;
#pragma unroll
                for (int r = 0; r < 16; ++r) acc[r] = 0.f;
#pragma unroll
                for (int ks = 0; ks < 4; ++ks) acc = MFMA32(*(const LAS bf16x8*)(Kl + swz_off<8>(32 * s + q32, 2 * ks + hh)), qf[ks], acc);
                const bool need_mask = (kbase + 31 >= qmin);
                float l[16];
#pragma unroll
                for (int r = 0; r < 16; ++r) { const float z = acc[r]; const float t = __builtin_amdgcn_exp2f(-fabsf(z)); const float u = __builtin_amdgcn_logf(1.0f + t);
                    float lr = -(fmaxf(z, 0.f) + u);
                    if (need_mask) lr = (kbase + crow(r, hh) < query) ? lr : 0.f;
                    l[r] = lr; }
#pragma unroll
                for (int g = 0; g < 4; ++g) { l[4 * g + 2] += l[4 * g + 3]; l[4 * g + 1] += l[4 * g + 2]; l[4 * g] += l[4 * g + 1]; }
                float Go[4], Tg[4];
#pragma unroll
                for (int g = 0; g < 4; ++g) { Go[g] = __shfl_xor(l[4 * g], 32); Tg[g] = l[4 * g] + Go[g]; }
                const float U2 = Tg[3], U1 = U2 + Tg[2], U0 = U1 + Tg[1], total = U0 + Tg[0];
                float off[4];
                off[3] = carry; off[2] = carry + U2; off[1] = carry + U1; off[0] = carry + U0;
                if (hh == 0) {
#pragma unroll
                    for (int g = 0; g < 4; ++g) off[g] += Go[g]; }
#pragma unroll
                for (int r = 0; r < 16; ++r) { float a = __builtin_amdgcn_exp2f(acc[r] + l[r] + off[r >> 2]);
                    if (need_mask) a = (kbase + crow(r, hh) < query) ? a : 0.f;
                    acc[r] = a; }
                carry += total;
                const bf16x8 pa0 = pack8<0>(acc), pa1 = pack8<1>(acc);
                const LAS unsigned char* vb = Vl + trb + (32 * s) * SB_VST;
                o0 = MFMA32(pa0, tr_frag(vb, SB_VST), o0);
                o1 = MFMA32(pa0, tr_frag(vb + 64, SB_VST), o1);
                o0 = MFMA32(pa1, tr_frag(vb + 16 * SB_VST, SB_VST), o0);
                o1 = MFMA32(pa1, tr_frag(vb + 16 * SB_VST + 64, SB_VST), o1);
            }
        }
        if (jt > 0) { LAS unsigned char* nb = F.lds + (cur ^ 1) * SB_BUF; *(LAS v4u*)(nb + kdst) = kn; *(LAS v4u*)(nb + vdst) = vn; }
        { const unsigned dw = (__all(carry < -SB_CUT) != 0) ? 1u : 0u;
          if (lane == 0) dflag[(jt & 1) * 8 + w] = dw; }
        __syncthreads();
        cur ^= 1;
        { unsigned alld = 1u;
#pragma unroll
          for (int i = 0; i < 8; ++i) alld &= dflag[(jt & 1) * 8 + i];
          if (alld) break; }
    }
    const float* g = F.in[I_SNG] + h * 64;
    const float g0 = g[q32], g1 = g[32 + q32];
#pragma unroll
    for (int r = 0; r < 16; ++r) { float v = o0[r] * o0[r] + o1[r] * o1[r]; v = row_sum_f(v); v = xadd16(v);
        const float rs = rsqrtf(v * (1.0f / 64.0f) + EPS);
        bf16* opb = MIXED + (rowbase + qmin) * D; const unsigned oo = (unsigned)crow(r, hh) * D + 512 + h * 64 + q32;
        opb[oo] = (bf16)f2bf(o0[r] * rs * g0); opb[oo + 32] = (bf16)f2bf(o1[r] * rs * g1); }
}
__device__ __forceinline__ void sb_phase(Frame& F, int qoff) {
    unsigned nxt = 0u;
    if (F.tid == 0) nxt = __hip_atomic_fetch_add((unsigned*)(F.ctl + CW_SBQ + qoff), 1u, __ATOMIC_RELAXED, __HIP_MEMORY_SCOPE_AGENT);
    for (;;) {
        __syncthreads();
        if (F.tid == 0) F.MISC[16] = nxt;
        __syncthreads();
        const int u = (int)F.MISC[16];
        if (u >= 1024) break;
        if (F.tid == 0) nxt = __hip_atomic_fetch_add((unsigned*)(F.ctl + CW_SBQ + qoff), 1u, __ATOMIC_RELAXED, __HIP_MEMORY_SCOPE_AGENT);
        const int qt = 15 - (u >> 6), bh = u & 63;
        sb_unit(F, bh >> 3, bh & 7, qt);
    }
}
__device__ __forceinline__ void p5_phase(Frame& F) {
    const int w = F.wave, qb = w >> 1, dh = w & 1;
    unsigned char* ws = F.ws;
    const bf16* QX = (const bf16*)(ws + WS_MIX); const bf16* KVX = (const bf16*)(ws + WS_KVX); bf16* OX = (bf16*)(ws + WS_OX);
    constexpr int XBUF = 32768 + 64 * 576;
    LAS float* wsf = (LAS float*)(F.lds + 2 * XBUF) + w * 64;
    constexpr int VST = 576;
    for (int u = F.vcu; u < 1024; u += F.G) {
        int lane = F.lane, tidx = F.tid; asm volatile("" : "+v"(lane), "+v"(tidx));
        const int q32 = lane & 31, hh = lane >> 5, trb = tr_base(lane, VST);
        const int tile = u >> 2, h = u & 3, t0 = tile * 128, b = t0 >> 12;
        bf16x8 qf[16];
        { const bf16* qp = QX + (size_t)(t0 + 32 * qb + q32) * D + h * 256 + 8 * hh;
#pragma unroll
          for (int ks = 0; ks < 16; ++ks) qf[ks] = *(const bf16x8*)(qp + 16 * ks); }
        f32x16 o[4];
#pragma unroll
        for (int i = 0; i < 4; ++i)
#pragma unroll
            for (int r = 0; r < 16; ++r) o[i][r] = 0.f;
        float m_run = -1e30f, l_run = 0.f;
        const int srow = tidx >> 5, sc = tidx & 31;
        const bf16* kvsrc = KVX + (size_t)(b * 256 + srow) * 2048 + h * 256 + sc * 8;
        v4u kn[4], vn[4];
#pragma unroll
        for (int i = 0; i < 4; ++i) { kn[i] = *(const GAS v4u*)(kvsrc + (size_t)(16 * i) * 2048); vn[i] = *(const GAS v4u*)(kvsrc + (size_t)(16 * i) * 2048 + 1024); }
#pragma unroll
        for (int i = 0; i < 4; ++i) { const int row = srow + 16 * i; *(LAS v4u*)(F.lds + swz_off<32>(row, sc)) = kn[i]; *(LAS v4u*)(F.lds + 32768 + row * VST + sc * 16) = vn[i]; }
        __syncthreads();
        int cur = 0;
#pragma unroll 1
        for (int kt = 0; kt < 4; ++kt) {
            if (kt < 3) {
#pragma unroll
                for (int i = 0; i < 4; ++i) { kn[i] = *(const GAS v4u*)(kvsrc + (size_t)(64 * (kt + 1) + 16 * i) * 2048); vn[i] = *(const GAS v4u*)(kvsrc + (size_t)(64 * (kt + 1) + 16 * i) * 2048 + 1024); } }
            const LAS unsigned char* Kl = F.lds + cur * XBUF; const LAS unsigned char* Vl = Kl + 32768;
            f32x16 s0, s1;
#pragma unroll
            for (int r = 0; r < 16; ++r) { s0[r] = 0.f; s1[r] = 0.f; }
#pragma unroll
            for (int ks = 0; ks < 16; ++ks) {
                const bf16x8 k0 = *(const LAS bf16x8*)(Kl + swz_off<32>(q32, 2 * ks + hh));
                const bf16x8 k1 = *(const LAS bf16x8*)(Kl + swz_off<32>(32 + q32, 2 * ks + hh));
                s0 = MFMA32(k0, qf[ks], s0); s1 = MFMA32(k1, qf[ks], s1);
            }
            float mx = fmaxf(s0[0], s1[0]);
#pragma unroll
            for (int r = 1; r < 16; ++r) mx = fmaxf(mx, fmaxf(s0[r], s1[r]));
            mx = xmax32(mx);
            const float m_new = fmaxf(m_run, mx), alpha = __builtin_amdgcn_exp2f(m_run - m_new);
            float rs = 0.f;
#pragma unroll
            for (int r = 0; r < 16; ++r) { s0[r] = __builtin_amdgcn_exp2f(s0[r] - m_new); s1[r] = __builtin_amdgcn_exp2f(s1[r] - m_new); rs += s0[r] + s1[r]; }
            rs = xadd32(rs);
            l_run = l_run * alpha + rs; m_run = m_new;
            if (hh == 0) wsf[q32] = alpha;
            asm volatile("s_waitcnt lgkmcnt(0)" ::: "memory");
#pragma unroll
            for (int r = 0; r < 16; ++r) { const float a = wsf[crow(r, hh)];
#pragma unroll
                for (int i = 0; i < 4; ++i) o[i][r] *= a; }
            const bf16x8 p00 = pack8<0>(s0), p01 = pack8<1>(s0), p10 = pack8<0>(s1), p11 = pack8<1>(s1);
#pragma unroll
            for (int i = 0; i < 4; ++i) { const LAS unsigned char* vb = Vl + trb + (dh * 128 + i * 32) * 2;
                o[i] = MFMA32(p00, tr_frag(vb, VST), o[i]);
                o[i] = MFMA32(p01, tr_frag(vb + 16 * VST, VST), o[i]);
                o[i] = MFMA32(p10, tr_frag(vb + 32 * VST, VST), o[i]);
                o[i] = MFMA32(p11, tr_frag(vb + 48 * VST, VST), o[i]); }
            if (kt < 3) { LAS unsigned char* nb = F.lds + (cur ^ 1) * XBUF;
#pragma unroll
                for (int i = 0; i < 4; ++i) { const int row = srow + 16 * i; *(LAS v4u*)(nb + swz_off<32>(row, sc)) = kn[i]; *(LAS v4u*)(nb + 32768 + row * VST + sc * 16) = vn[i]; } }
            __syncthreads();
            cur ^= 1;
        }
        if (hh == 0) wsf[32 + q32] = l_run;
        asm volatile("s_waitcnt lgkmcnt(0)" ::: "memory");
#pragma unroll
        for (int r = 0; r < 16; ++r) { const float inv = 1.0f / wsf[32 + crow(r, hh)];
            bf16* op = OX + (size_t)(t0 + 32 * qb + crow(r, hh)) * D + h * 256 + dh * 128 + q32;
#pragma unroll
            for (int i = 0; i < 4; ++i) op[i * 32] = (bf16)f2bf(o[i][r] * inv); }
    }
    __syncthreads();
}
#define P5_BODY p5_phase(F);
typedef __bf16 bf16v2 __attribute__((ext_vector_type(2)));

__device__ __forceinline__ unsigned f16_sortable(unsigned s) { return (s & 0x8000u) ? (s ^ 0xFFFFu) : (s | 0x8000u); }
__device__ __forceinline__ float sortable_f16_to_f32(unsigned m) { const unsigned s = (m & 0x8000u) ? (m ^ 0x8000u) : (m ^ 0xFFFFu); return (float)__builtin_bit_cast(_Float16, (unsigned short)s); }
__device__ __forceinline__ unsigned f32_sortable(float f) { const unsigned b = __builtin_bit_cast(unsigned, f); return (b & 0x80000000u) ? ~b : (b | 0x80000000u); }
__device__ __forceinline__ float gelu_erf(float v) {
    const float av = fabsf(v), t = __builtin_amdgcn_rcpf(av * 0.2316418882f + 1.0f);
    float q = t * 0.5307027145f + (-0.7265760135f); q = q * t + 0.7107068705f; q = q * t + (-0.142248368f); q = q * t + 0.127414796f; q = q * t;
    const float e = __builtin_amdgcn_exp2f((v * v) * (-0.72134752044f));
    const float m = v * (q * e);
    return v < 0.f ? m : v - m;
}

constexpr int CW_P8S = 16384;
#ifndef P8_SYNC_EVERY
#define P8_SYNC_EVERY 0
#endif
__device__ __forceinline__ void p8_group_sync(Frame& F, unsigned target, int slot) {
    __syncthreads();
    if (F.tid == 0) {
        unsigned* c = (unsigned*)(F.ctl + CW_P8S + slot * 256) + (F.vcu / (F.G / 8)) * 32;
        __hip_atomic_fetch_add(c, 1u, __ATOMIC_RELAXED, __HIP_MEMORY_SCOPE_AGENT);
        while (__hip_atomic_load(c, __ATOMIC_RELAXED, __HIP_MEMORY_SCOPE_AGENT) < target) __builtin_amdgcn_s_sleep(1);
    }
    __syncthreads();
}
template <unsigned EMASK, int SLOT = 0, int NOCOMP = 0> __device__ __forceinline__ void p8_phase(Frame& F, float* XOUT) {
    const int gw = F.vcu * NWAVES + F.wave, NGW = F.G * NWAVES;
    LAS unsigned char* wl = F.lds + F.wave * 12288;
    LAS unsigned* sk = (LAS unsigned*)(wl + 2048);
    LAS unsigned* peA = (LAS unsigned*)wl; LAS float* pgA = (LAS float*)(wl + 512); LAS unsigned* peB = (LAS unsigned*)(wl + 1024); LAS float* pgB = (LAS float*)(wl + 1536);
    LAS float* xnA = (LAS float*)(wl + 4096); LAS float* xnB = (LAS float*)(wl + 8192);
    LAS float* psA = (LAS float*)(wl + 3072); LAS float* psB = (LAS float*)(wl + 3584);
    unsigned char* ws = F.ws;
    const unsigned short* SC = (const unsigned short*)(ws + WS_SC); const float* ssq2 = (const float*)(ws + WS_SSQ2);
    const float* fg = F.in[I_FFNG]; const float* fing = F.in[I_FING]; const bf16* X = (const bf16*)(ws + WS_XB);
    const unsigned char* UB = ws + WS_UB;
    const float* USC = (const float*)(ws + WS_USC);
    v4u raw4n[4];
    if (gw < T) { const int lane0 = F.lane;
#pragma unroll
        for (int bi = 0; bi < 4; ++bi) raw4n[bi] = *(const GAS v4u*)(SC + (size_t)gw * 2048 + bi * 512 + lane0 * 8); }
    unsigned sweep_rev = 0u;
    for (int tA = gw; tA < T; tA += 2 * NGW) {
        const int tB = (tA + NGW < T) ? tA + NGW : tA;
#pragma unroll 1
        for (int w = 0; w < 2; ++w) {
            const int t = w ? tB : tA;
            int lane = F.lane; asm volatile("" : "+v"(lane));
            const int j16 = lane & 15;
            LAS unsigned* pe = w ? peB : peA; LAS float* pg = w ? pgB : pgA; LAS float* ps = w ? psB : psA;
            u32x2f xb[4]; { const GAS u32x2f* xr = (const GAS u32x2f*)(X + (size_t)t * D) + lane;
#pragma unroll
              for (int j = 0; j < 4; ++j) xb[j] = xr[64 * j]; }
            float ssq_t; { const f32x4* sp = (const f32x4*)(ssq2 + (size_t)t * 16); const f32x4 a = sp[0], b = sp[1], c = sp[2], d = sp[3]; ssq_t = ((a[0] + a[1]) + (a[2] + a[3])) + ((b[0] + b[1]) + (b[2] + b[3])) + ((c[0] + c[1]) + (c[2] + c[3])) + ((d[0] + d[1]) + (d[2] + d[3])); }
            v4u raw4[4];
#pragma unroll
            for (int bi = 0; bi < 4; ++bi) raw4[bi] = raw4n[bi];
            if (w == 0) {
#pragma unroll
                for (int bi = 0; bi < 4; ++bi) raw4n[bi] = *(const GAS v4u*)(SC + (size_t)tB * 2048 + bi * 512 + lane * 8); }
        __builtin_amdgcn_s_setprio(2);
#define CE_(k, i_, j_) do { const unsigned hi_ = max(k[i_], k[j_]), lo_ = min(k[i_], k[j_]); k[i_] = hi_; k[j_] = lo_; } while (0)
#define SORT8_(k) do { CE_(k, 0, 1); CE_(k, 2, 3); CE_(k, 4, 5); CE_(k, 6, 7); CE_(k, 0, 2); CE_(k, 1, 3); CE_(k, 4, 6); CE_(k, 5, 7); CE_(k, 1, 2); CE_(k, 5, 6); CE_(k, 0, 4); CE_(k, 3, 7); \
                CE_(k, 1, 5); CE_(k, 2, 6); CE_(k, 1, 4); CE_(k, 3, 6); CE_(k, 2, 4); CE_(k, 3, 5); CE_(k, 3, 4); } while (0)
            {
                unsigned k0[8], k1[8], k2[8], k3[8];
#pragma unroll
                for (int e = 0; e < 8; ++e) { const unsigned lo = (unsigned)(255 - (j16 * 8 + e));
#define KEY_(b_) ((f16_sortable((e & 1) ? (raw4[b_][e >> 1] >> 16) : (raw4[b_][e >> 1] & 0xFFFFu)) << 16) | lo)
                    k0[e] = KEY_(0); k1[e] = KEY_(1); k2[e] = KEY_(2); k3[e] = KEY_(3); }
#undef KEY_
                SORT8_(k0); SORT8_(k1); SORT8_(k2); SORT8_(k3);
                unsigned mine0 = 0u, mine1 = 0u, mine2 = 0u, mine3 = 0u;
#pragma unroll 1
                for (int r = 0; r < 16; ++r) {
                    const unsigned m0 = row_max_u(k0[0]), m1 = row_max_u(k1[0]), m2 = row_max_u(k2[0]), m3 = row_max_u(k3[0]);
                    const bool me = (j16 == r);
                    mine0 = me ? m0 : mine0; mine1 = me ? m1 : mine1; mine2 = me ? m2 : mine2; mine3 = me ? m3 : mine3;
                    const bool wn0 = (k0[0] == m0), wn1 = (k1[0] == m1), wn2 = (k2[0] == m2), wn3 = (k3[0] == m3);
#pragma unroll
                    for (int e = 0; e < 7; ++e) { k0[e] = wn0 ? k0[e + 1] : k0[e]; k1[e] = wn1 ? k1[e + 1] : k1[e]; k2[e] = wn2 ? k2[e + 1] : k2[e]; k3[e] = wn3 ? k3[e + 1] : k3[e]; }
                    k0[7] = wn0 ? 0u : k0[7]; k1[7] = wn1 ? 0u : k1[7]; k2[7] = wn2 ? 0u : k2[7]; k3[7] = wn3 ? 0u : k3[7];
                }
                const int rr = lane >> 4, hf = (rr & 1) * 128, hb = (rr >> 1) * 16 + j16;
                sk[hf + hb] = mine0; sk[hf + 32 + hb] = mine1; sk[hf + 64 + hb] = mine2; sk[hf + 96 + hb] = mine3;
            }
#undef SORT8_
#undef CE_
            asm volatile("s_waitcnt lgkmcnt(0)" ::: "memory");
            {
                const unsigned tbl = (j16 == 0) ? 0x30201000u : (j16 == 1) ? 0x70605040u : (j16 == 2) ? 0xB0A09080u : (j16 == 3) ? 0xF0E0D0C0u : (j16 == 4) ? 0x31211101u : (j16 == 5) ? 0x71615141u
                                   : (j16 == 6) ? 0xFF221202u : (j16 == 7) ? 0xFFFF4232u : (j16 == 8) ? 0x33231303u : (j16 == 9) ? 0xFF241404u : (j16 == 10) ? 0xFFFF1505u : (j16 == 11) ? 0xFFFF1606u
                                   : (j16 == 12) ? 0xFFFF1707u : (j16 == 13) ? 0x0B0A0908u : (j16 == 14) ? 0x0F0E0D0Cu : 0xFFFFFFFFu;
                const int h0 = lane >> 4, h1 = 4 + (lane >> 4);
                const LAS unsigned* ska0 = sk + h0 * 16; const LAS unsigned* skb0 = sk + 128 + h0 * 16; const LAS unsigned* ska1 = sk + h1 * 16; const LAS unsigned* skb1 = sk + 128 + h1 * 16;
                unsigned c0[4], c1[4];
#pragma unroll
                for (int q = 0; q < 4; ++q) { const unsigned ent = (tbl >> (8 * q)) & 0xFFu; const bool ok = (ent != 0xFFu); const int ci = ok ? (int)(ent >> 4) : 0, cj = ok ? (int)(ent & 15u) : 0;
                    const float cv0 = sortable_f16_to_f32(ska0[ci] >> 16) + sortable_f16_to_f32(skb0[cj] >> 16), cv1 = sortable_f16_to_f32(ska1[ci] >> 16) + sortable_f16_to_f32(skb1[cj] >> 16);
                    const unsigned lo = (unsigned)(255 - (ci * 16 + cj));
                    c0[q] = ok ? ((f32_sortable(cv0) & ~0xFFu) | lo) : 0u; c1[q] = ok ? ((f32_sortable(cv1) & ~0xFFu) | lo) : 0u; }
                unsigned win0 = 0u, win1 = 0u;
#pragma unroll 1
                for (int r = 0; r < 16; ++r) {
                    const unsigned m0 = row_max_u(c0[0]), m1 = row_max_u(c1[0]);
                    win0 = (j16 == r) ? m0 : win0; win1 = (j16 == r) ? m1 : win1;
                    const bool wn0 = (c0[0] == m0), wn1 = (c1[0] == m1);
#pragma unroll
                    for (int i = 0; i < 3; ++i) { c0[i] = wn0 ? c0[i + 1] : c0[i]; c1[i] = wn1 ? c1[i + 1] : c1[i]; }
                    c0[3] = wn0 ? 0u : c0[3]; c1[3] = wn1 ? 0u : c1[3];
                }
#define FIN_(win, ska, skb, head) do { const int pos = 255 - (int)(win & 0xFFu); const unsigned kA = ska[pos >> 4], kB = skb[pos & 15]; \
                    const float best = sortable_f16_to_f32(kA >> 16) + sortable_f16_to_f32(kB >> 16); \
                    const unsigned expert = (255u - (kA & 0xFFFFu)) * 128u + (255u - (kB & 0xFFFFu)); \
                    const float mx = sortable_f16_to_f32(ska[0] >> 16) + sortable_f16_to_f32(skb[0] >> 16);        \
                    const float ex = __builtin_amdgcn_exp2f((best - mx) * LOG2E); const float sum = row_sum_f(ex); \
                    pe[(head) * 16 + j16] = expert; pg[(head) * 16 + j16] = ex / sum; } while (0)
                FIN_(win0, ska0, skb0, h0); FIN_(win1, ska1, skb1, h1);
#undef FIN_
            }
            {
                asm volatile("s_waitcnt lgkmcnt(0)" ::: "memory");
                const unsigned e0 = pe[lane], e1 = pe[lane + 64]; const float g0 = pg[lane], g1 = pg[lane + 64];
                const f32x2_t sc0 = *(const GAS f32x2_t*)(USC + 2 * e0), sc1 = *(const GAS f32x2_t*)(USC + 2 * e1);
                const unsigned b0 = (e0 >> 9) ^ sweep_rev, b1 = (e1 >> 9) ^ sweep_rev;
                if (lane < 32) sk[lane] = 0u;
                asm volatile("s_waitcnt lgkmcnt(0)" ::: "memory");
                const unsigned r0 = __hip_atomic_fetch_add(sk + b0, 1u, __ATOMIC_RELAXED, __HIP_MEMORY_SCOPE_WAVEFRONT), r1 = __hip_atomic_fetch_add(sk + b1, 1u, __ATOMIC_RELAXED, __HIP_MEMORY_SCOPE_WAVEFRONT);
                asm volatile("s_waitcnt lgkmcnt(0)" ::: "memory");
                const unsigned cnt = sk[lane & 31];
                unsigned inc = cnt;
                inc += (unsigned)__builtin_amdgcn_update_dpp(0, (int)inc, 0x111, 0xf, 0xf, true); inc += (unsigned)__builtin_amdgcn_update_dpp(0, (int)inc, 0x112, 0xf, 0xf, true);
                inc += (unsigned)__builtin_amdgcn_update_dpp(0, (int)inc, 0x114, 0xf, 0xf, true); inc += (unsigned)__builtin_amdgcn_update_dpp(0, (int)inc, 0x118, 0xf, 0xf, true);
                const unsigned row0tot = (unsigned)__builtin_amdgcn_readlane((int)inc, 15);
                if (lane & 16) inc += row0tot;
                if (lane < 32) sk[32 + lane] = inc - cnt;
                asm volatile("s_waitcnt lgkmcnt(0)" ::: "memory");
                const unsigned pos0 = sk[32 + b0] + r0, pos1 = sk[32 + b1] + r1;
                asm volatile("s_waitcnt lgkmcnt(0)" ::: "memory");
                pe[pos0] = e0; pg[pos0] = g0 * sc0.y; ps[pos0] = sc0.x; pe[pos1] = e1; pg[pos1] = g1 * sc1.y; ps[pos1] = sc1.x;
            }
            asm volatile("s_waitcnt lgkmcnt(0)" ::: "memory");
            __builtin_amdgcn_s_setprio(0);
            { const float r2 = rsqrtf(ssq_t * (1.0f / D) + EPS); const float* gr = fg + lane * 4; LAS f32x4* xo = (LAS f32x4*)(w ? xnB : xnA) + lane;
#pragma unroll
              for (int j = 0; j < 4; ++j) { const f32x4 xj = (f32x4){bf_lo(xb[j].x), bf_hi(xb[j].x), bf_lo(xb[j].y), bf_hi(xb[j].y)}; xo[64 * j] = xj * r2 * *(const f32x4*)(gr + 256 * j); } }
        }
        asm volatile("s_waitcnt lgkmcnt(0)" ::: "memory");
        int lane = F.lane; asm volatile("" : "+v"(lane));
        f32x2_t y2A[8], y2B[8];
#pragma unroll
        for (int i = 0; i < 8; ++i) { y2A[i] = (f32x2_t){0.f, 0.f}; y2B[i] = (f32x2_t){0.f, 0.f}; }
        v4u pa[4], pb[4]; u32x2f qa[4], qb[4]; f32x2_t sa, sb;
#define P8_LOAD(P_, Q_, SC_, PE_, s) do { _Pragma("unroll") for (int q_ = 0; q_ < 4; ++q_) { const unsigned e_ = (unsigned)__builtin_amdgcn_readfirstlane((int)PE_[(s) + q_]) & EMASK; \
            const unsigned char* r_ = UB + (size_t)e_ * 1536; P_[q_] = *(const GAS v4u*)(r_ + lane * 16); Q_[q_] = *(const GAS u32x2f*)(r_ + 1024 + lane * 8); } \
            { const unsigned el_ = PE_[(s) + (lane & 3)] & EMASK; SC_ = *(const GAS f32x2_t*)(USC + 2 * el_); } } while (0)
#define P8_XN(XN_) do { const LAS f32x4* xp_ = (const LAS f32x4*)(XN_) + lane; _Pragma("unroll") for (int i_ = 0; i_ < 4; ++i_) { const f32x4 v_ = xp_[64 * i_]; xn2[2 * i_] = (f32x2_t){v_.x, v_.y}; xn2[2 * i_ + 1] = (f32x2_t){v_.z, v_.w}; } \
            __builtin_amdgcn_sched_barrier(0); } while (0)
#define P8_PROC(P_, Q_, SC_, PG_, Y_, s) do { float d_[4]; f32x2_t vh_[4][8]; \
            _Pragma("unroll") for (int q_ = 0; q_ < 4; ++q_) { const f32x32 z_ = __builtin_amdgcn_cvt_scalef32_pk32_f32_fp6((u32x6){P_[q_][0], P_[q_][1], P_[q_][2], P_[q_][3], Q_[q_][0], Q_[q_][1]}, 1.0f); \
                f32x2_t a2_ = (f32x2_t){0.f, 0.f}; \
                _Pragma("unroll") for (int i_ = 0; i_ < 8; ++i_) { a2_ += (f32x2_t){z_[2 * i_], z_[2 * i_ + 1]} * xn2[i_]; vh_[q_][i_] = (f32x2_t){z_[16 + 2 * i_], z_[17 + 2 * i_]}; } \
                d_[q_] = a2_.x + a2_.y; __builtin_amdgcn_sched_barrier(0); } \
              \
            float dsel_; { const bool o1_ = (lane & 1) != 0, o2_ = (lane & 2) != 0; \
              const float k01_ = o1_ ? d_[1] : d_[0], s01_ = o1_ ? d_[0] : d_[1], k23_ = o1_ ? d_[3] : d_[2], s23_ = o1_ ? d_[2] : d_[3]; \
              const float b_ = k01_ + DPP_F(s01_, 0xB1), c_ = k23_ + DPP_F(s23_, 0xB1); \
              const float kk_ = o2_ ? c_ : b_, ss_ = o2_ ? b_ : c_; \
              float r_ = kk_ + DPP_F(ss_, 0x4E); \
              r_ += DPP_F(r_, 0x124); r_ += DPP_F(r_, 0x128);              \
              r_ = xadd16(r_); r_ = xadd32(r_); dsel_ = r_; } \
            const float act_ = gelu_erf(dsel_ * SC_.x) * (SC_.y * PG_[(s) + (lane & 3)]);        \
            _Pragma("unroll") for (int q_ = 0; q_ < 4; ++q_) { const float a_ = __builtin_bit_cast(float, __builtin_amdgcn_readlane(__builtin_bit_cast(int, act_), q_)); const f32x2_t aa_ = (f32x2_t){a_, a_}; \
                _Pragma("unroll") for (int i_ = 0; i_ < 8; ++i_) Y_[i_] += aa_ * vh_[q_][i_]; } } while (0)
#define P8_PROCL(P_, Q_, PS_, PG_, Y_, s, NP_, NQ_, NPE_, ns) do { float d_[4]; f32x2_t vh_[4][8]; \
            if (NOCOMP) { const v4u evn_ = *(const LAS v4u*)(NPE_ + (ns)); _Pragma("unroll") for (int q_ = 0; q_ < 4; ++q_) { float t_ = __builtin_bit_cast(float, P_[q_][0] ^ Q_[q_][0]); Y_[q_].x += t_; \
                const unsigned e_ = (unsigned)__builtin_amdgcn_readfirstlane((int)evn_[q_]) & EMASK; const unsigned char* r_ = UB + (size_t)e_ * 1536; NP_[q_] = *(const GAS v4u*)(r_ + lane * 16); NQ_[q_] = *(const GAS u32x2f*)(r_ + 1024 + lane * 8); } } else { \
            const float suc_ = PS_[(s) + (lane & 3)], gvc_ = PG_[(s) + (lane & 3)];        \
            const v4u ev_ = *(const LAS v4u*)(NPE_ + (ns));        \
            _Pragma("unroll") for (int q_ = 0; q_ < 4; ++q_) { const f32x32 z_ = __builtin_amdgcn_cvt_scalef32_pk32_f32_fp6((u32x6){P_[q_][0], P_[q_][1], P_[q_][2], P_[q_][3], Q_[q_][0], Q_[q_][1]}, 1.0f); \
                f32x2_t a2_ = (f32x2_t){0.f, 0.f}, b2_ = (f32x2_t){0.f, 0.f};        \
                _Pragma("unroll") for (int i_ = 0; i_ < 4; ++i_) { a2_ += (f32x2_t){z_[4 * i_], z_[4 * i_ + 1]} * xn2[2 * i_]; b2_ += (f32x2_t){z_[4 * i_ + 2], z_[4 * i_ + 3]} * xn2[2 * i_ + 1]; } \
                _Pragma("unroll") for (int i_ = 0; i_ < 8; ++i_) vh_[q_][i_] = (f32x2_t){z_[16 + 2 * i_], z_[17 + 2 * i_]}; \
                d_[q_] = (a2_.x + b2_.x) + (a2_.y + b2_.y); __builtin_amdgcn_sched_barrier(0); \
                { const unsigned e_ = (unsigned)__builtin_amdgcn_readfirstlane((int)ev_[q_]) & EMASK; const GAS unsigned char* r_ = (const GAS unsigned char*)UB + (size_t)e_ * 1536; unsigned l16_ = lo16, l8_ = lo8; asm volatile("" : "+v"(l16_), "+v"(l8_));        \
                  NP_[q_] = *(const GAS v4u*)(r_ + l16_); NQ_[q_] = *(const GAS u32x2f*)(r_ + 1024 + l8_); } \
                __builtin_amdgcn_sched_barrier(0); } \
              \
            float dsel_; { const bool o1_ = (lane & 1) != 0, o2_ = (lane & 2) != 0; \
              const float k01_ = o1_ ? d_[1] : d_[0], s01_ = o1_ ? d_[0] : d_[1], k23_ = o1_ ? d_[3] : d_[2], s23_ = o1_ ? d_[2] : d_[3]; \
              const float b_ = k01_ + DPP_F(s01_, 0xB1), c_ = k23_ + DPP_F(s23_, 0xB1); \
              const float kk_ = o2_ ? c_ : b_, ss_ = o2_ ? b_ : c_; \
              float r_ = kk_ + DPP_F(ss_, 0x4E); \
              r_ += DPP_F(r_, 0x124); r_ += DPP_F(r_, 0x128);              \
              r_ = xadd16(r_); r_ = xadd32(r_); dsel_ = r_; } \
            const float act_ = gelu_erf(dsel_ * suc_) * gvc_;        \
            _Pragma("unroll") for (int q_ = 0; q_ < 4; ++q_) { const float a_ = __builtin_bit_cast(float, __builtin_amdgcn_readlane(__builtin_bit_cast(int, act_), q_)); const f32x2_t aa_ = (f32x2_t){a_, a_}; \
                if (NOCOMP != 2) { _Pragma("unroll") for (int i_ = 0; i_ < 8; ++i_) Y_[i_] += aa_ * vh_[q_][i_]; } else Y_[q_].x += aa_.x; } } } while (0)
        const unsigned lo16 = (unsigned)lane * 16u, lo8 = (unsigned)lane * 8u;
        f32x2_t xn2[8];
        P8_LOAD(pa, qa, sa, peA, 0); P8_LOAD(pb, qb, sb, peB, 0);
#pragma unroll 1
        for (int s = 0; s < 128; s += 4) {
            const int sn = min(s + 4, 124);
            P8_XN(xnA);
            P8_PROCL(pa, qa, psA, pgA, y2A, s, pa, qa, peA, sn);
            if (F.G == 0x7ffffff1) asm volatile("s_nop 0");
            P8_XN(xnB);
            P8_PROCL(pb, qb, psB, pgB, y2B, s, pb, qb, peB, sn);
        }
#undef P8_PROCL
#undef P8_LOAD
#undef P8_PROC
#undef P8_XN
        { const int tn = (tA + 2 * NGW < T) ? tA + 2 * NGW : tA;
#pragma unroll
            for (int bi = 0; bi < 4; ++bi) raw4n[bi] = *(const GAS v4u*)(SC + (size_t)tn * 2048 + bi * 512 + lane * 8); }
#define P8_EPI(t_, Y_) do { f32x4 xv[4]; \
        { const GAS u32x2f* xr = (const GAS u32x2f*)(X + (size_t)(t_) * D) + lane; \
          _Pragma("unroll") for (int i = 0; i < 4; ++i) { const u32x2f b_ = xr[64 * i]; xv[i] = (f32x4){bf_lo(b_.x), bf_hi(b_.x), bf_lo(b_.y), bf_hi(b_.y)}; } } \
        float ss = 0.f; \
        _Pragma("unroll") for (int i = 0; i < 4; ++i) { xv[i].x += Y_[2 * i].x; xv[i].y += Y_[2 * i].y; xv[i].z += Y_[2 * i + 1].x; xv[i].w += Y_[2 * i + 1].y; ss += (xv[i].x * xv[i].x + xv[i].y * xv[i].y) + (xv[i].z * xv[i].z + xv[i].w * xv[i].w); } \
        ss = wave_sum_dpp(ss); \
        const float rf = rsqrtf(ss * (1.0f / D) + EPS); \
        { float* xr = XOUT + (size_t)(t_) * D + lane * 4; const float* gr = fing + lane * 4; \
          _Pragma("unroll") for (int i = 0; i < 4; ++i) { const f32x4 g4 = *(const f32x4*)(gr + 256 * i); f32x4 o; o.x = xv[i].x * rf * g4.x; o.y = xv[i].y * rf * g4.y; o.z = xv[i].z * rf * g4.z; o.w = xv[i].w * rf * g4.w; *(f32x4*)(xr + 256 * i) = o; } } } while (0)
        P8_EPI(tA, y2A);
        P8_EPI(tB, y2B);
        sweep_rev ^= 31u;
#undef P8_EPI
    }
}
#if REPEAT == 10
#define P8_BODY p8_phase<0xFFFFFFFFu, 0>(F, F.out); p8_phase<0xFFFFFFFFu, 1>(F, F.out);
#elif REPEAT == 11
#define P8_BODY p8_phase<2047u, 0>(F, F.out); p8_phase<0xFFFFFFFFu, 1>(F, F.out);
#elif REPEAT == 13
#define P8_BODY p8_phase<0u, 0>(F, F.out); p8_phase<0xFFFFFFFFu, 1>(F, F.out);
#elif REPEAT == 14
#define P8_BODY p8_phase<0xFFFFFFFFu, 0, 1>(F, F.out); p8_phase<0xFFFFFFFFu, 1>(F, F.out);
#elif REPEAT == 15
#define P8_BODY p8_phase<2047u, 0, 1>(F, F.out); p8_phase<0xFFFFFFFFu, 1>(F, F.out);
#elif REPEAT == 16
#define P8_BODY p8_phase<0xFFFFFFFFu, 0, 2>(F, F.out); p8_phase<0xFFFFFFFFu, 1>(F, F.out);

#else
#define P8_BODY p8_phase<0xFFFFFFFFu>(F, F.out);
#endif
struct Args { const float* in[22]; float* out; unsigned char* ws; int ph_lo, ph_hi, li, pad; };
constexpr int N_PHASES = 11;
__global__ void __launch_bounds__(NWAVES * 64, 2) skel_fwd(Args args) {
    extern __shared__ __attribute__((aligned(16))) unsigned char lds[];
    Frame F;
    F.lds = (LAS unsigned char*)lds;
    F.MISC = (volatile LAS unsigned*)(F.lds + MISC_OFF);
    F.tid = threadIdx.x; F.lane = F.tid & 63; F.wave = __builtin_amdgcn_readfirstlane(F.tid >> 6);
    F.G = gridDim.x; { const int bx = blockIdx.x; F.vcu = (F.G % 8 == 0) ? (bx % 8) * (F.G / 8) + bx / 8 : bx; }
    unsigned char* ws = args.ws; F.ws = ws; F.out = args.out;
    F.ctl = (gu32*)(ws + WS_CTL);
#pragma unroll
    for (int i = 0; i < 22; ++i) F.in[i] = args.in[i];
    for (int u = F.tid; u < (LDS_BYTES - LDSCTL_OFF) / 4; u += NWAVES * 64) ((LAS unsigned*)(F.lds + LDSCTL_OFF))[u] = 0u;
    __syncthreads();
    const int lo = args.ph_lo, hi = args.ph_hi;
    const bool use_bar = (hi - lo) > 1;
    XcdBarrier bar; bar.bar = (unsigned*)(F.ctl + CW_BAR) + args.li * XCD_BAR_WORDS; bar.x = 0; bar.st = nullptr;
    if (use_bar) bar = xcd_barrier_post((unsigned*)(F.ctl + CW_BAR) + args.li * XCD_BAR_WORDS, F.MISC + 8);
#define IN(k) (lo <= (k) && (k) < hi)
#define BOTH(k) (IN(k) && IN((k) + 1))
#define GRID_BAR() xcd_barrier(bar)
    bf16* XB = (bf16*)(ws + WS_XB); bf16* MIXED = (bf16*)(ws + WS_MIX); bf16* QX = MIXED;
    bf16* PROJ = (bf16*)(ws + WS_PROJ); bf16* OX = (bf16*)(ws + WS_OX); bf16* SC = (bf16*)(ws + WS_SC);
    float* ssq0 = (float*)(ws + WS_SSQ0); float* ssq1 = (float*)(ws + WS_SSQ1); float* ssq2 = (float*)(ws + WS_SSQ2);

#ifndef REPEAT
#define REPEAT -1
#endif
    if (IN(0)) { p0_prologue(F);
#if REPEAT == 0
        __syncthreads(); p0_prologue(F);
#endif
        if (BOTH(0)) GRID_BAR(); }
    if (IN(1)) {
        { pg8::Gemm g{XB, (const bf16*)(ws + WS_WIN), T, PROJ_N, D}; pg8::StaticOrder S; S.init(T, PROJ_N, F.G, (int)blockIdx.x);
          pg8::EpiRow<false> E{PROJ, PROJ_N, ssq0, 1};
          pg8::gemm_phase<pg8::EpiRow<false>, pg8::StaticOrder, true, true>(F.lds, g, S, E);
#if REPEAT == 1
          __syncthreads(); pg8::gemm_phase<pg8::EpiRow<false>, pg8::StaticOrder, true, true>(F.lds, g, S, E);
#endif
        }
        if (BOTH(1)) GRID_BAR();
    }
    if (IN(2)) { ml_passA(F);
#if REPEAT == 2
        ml_passA(F);
#endif
        if (BOTH(2)) GRID_BAR(); }
    if (IN(3)) { ml_passB(F);
#if REPEAT == 3
        ml_passB(F);
#endif
        if (BOTH(3)) GRID_BAR(); }
    if (IN(4)) {
        { pg8::Gemm g{(const bf16*)(ws + WS_MEMN), (const bf16*)(ws + WS_WKV), 2048, 2048, D}; pg8::StaticOrder S; S.init(2048, 2048, F.G, (int)blockIdx.x);
          pg8::EpiBlk E{(bf16*)(ws + WS_KVX), 8};
          pg8::gemm_phase<pg8::EpiBlk, pg8::StaticOrder, true, true>(F.lds, g, S, E); }
        ml_passC(F);
#if REPEAT == 4
        ml_passC(F);
#endif
        sb_phase(F, 0);
#if REPEAT == 21
        GRID_BAR(); sb_phase(F, 64);
#endif
        if (BOTH(4)) GRID_BAR();
    }
    if (IN(5)) {
        for (int it = F.vcu; it < 256; it += F.G) {
            const int which = it >> 7, rem = it & 127, bh = rem >> 2, q = rem & 3, b = bh >> 2, h = bh & 3;
            const bf16* KVB = (const bf16*)(ws + WS_KVX);
            const bf16* WQB = (const bf16*)(ws + WS_WQ) + (size_t)h * 262144; const bf16* WOB = (const bf16*)(ws + WS_WO) + (size_t)h * 262144;
            const bf16* Kb = KVB + (size_t)(b * 8 + h) * 65536; const bf16* Vb = KVB + (size_t)(b * 8 + 4 + h) * 65536;
            pg8::Gemm g{which ? WOB : Kb, which ? Vb : WQB, which ? 1024 : 256, which ? 256 : 1024, 256};
            pg8::OneUnit S{which ? q : 0, which ? 0 : q};
            pg8::EpiRow<false> E{which ? (bf16*)(ws + WS_M2) + (size_t)b * 1048576 + (size_t)h * 256 : (bf16*)(ws + WS_M1) + (size_t)b * 1048576 + (size_t)h * 262144, 1024, nullptr, 1};
            pg8::gemm_phase<pg8::EpiRow<false>, pg8::OneUnit, true, true>(F.lds, g, S, E);
            __syncthreads();
        }
        pg8::Gemm g{MIXED, (const bf16*)(ws + WS_WOUT), T, D, D}; pg8::StaticOrder S; S.init(T, D, F.G, (int)blockIdx.x);
        pg8::EpiRes<true> E{XB, XB, ssq1, D};
        pg8::gemm_phase<pg8::EpiRes<true>, pg8::StaticOrder, true, true>(F.lds, g, S, E);
        if (BOTH(5)) GRID_BAR();
    }
    if (IN(6)) {
        pg8::Gemm g{XB, (const bf16*)(ws + WS_M1), T, D, D, 4, (size_t)2 * 1024 * 1024}; pg8::StaticOrder S; S.init(T, D, F.G, (int)blockIdx.x);
        pg8::EpiSoftmax E{QX, D, ssq1, (LAS float*)(F.lds + 131072)};
        pg8::gemm_phase<pg8::EpiSoftmax, pg8::StaticOrder, true, true>(F.lds, g, S, E);
        if (BOTH(6)) GRID_BAR();
    }
    if (IN(8)) {
        pg8::Gemm g{QX, (const bf16*)(ws + WS_M2), T, D, D, 4, (size_t)2 * 1024 * 1024}; pg8::StaticOrder S; S.init(T, D, F.G, (int)blockIdx.x);
        pg8::EpiRes<true> E{XB, XB, ssq2, D};
        pg8::gemm_phase<pg8::EpiRes<true>, pg8::StaticOrder, true, true>(F.lds, g, S, E);
        if (BOTH(8)) GRID_BAR();
    }
    if (IN(9)) {
        pg8::Gemm g{XB, (const bf16*)(ws + WS_WPS), T, 2048, D}; pg8::StaticOrder S; S.init(T, 2048, F.G, (int)blockIdx.x);
        pg8::EpiRow<true> E{SC, 2048, ssq2, 16};
        pg8::gemm_phase<pg8::EpiRow<true>, pg8::StaticOrder, true, true>(F.lds, g, S, E);
#if REPEAT == 9
        __syncthreads(); pg8::gemm_phase<pg8::EpiRow<true>, pg8::StaticOrder, true, true>(F.lds, g, S, E);
#endif
        if (BOTH(9)) GRID_BAR();
    }
    if (IN(10)) { P8_BODY }
#undef IN
#undef BOTH
}

static void launch_phases(const Args& base, int lo, int hi, int li, int grid, hipStream_t stream) {
    Args a = base; a.ph_lo = lo; a.ph_hi = hi; a.li = li;
    hipLaunchKernelGGL(skel_fwd, dim3(grid), dim3(NWAVES * 64), LDS_BYTES, stream, a);
    const hipError_t le = hipPeekAtLastError();
    if (le != hipSuccess) fprintf(stderr, "kernel_launch: launch [%d,%d) failed: %s\n", lo, hi, hipGetErrorName(le));
}

extern "C" void kernel_launch(void* const* d_in, const int* in_sizes, int n_in, void* d_out, int out_size, void* d_ws, size_t ws_size, hipStream_t stream) {
    static int grid = 0;
    if (grid == 0) {
        if (n_in != 22 || in_sizes[0] != T * D || out_size != T * D || ws_size < WS_END) { fprintf(stderr, "kernel_launch: unexpected shapes (n_in %d, ws %zu)\n", n_in, ws_size); grid = -1; return; }
        int dev = 0, cus = 0, per_cu = 0;
        if (hipGetDevice(&dev) != hipSuccess || hipDeviceGetAttribute(&cus, hipDeviceAttributeMultiprocessorCount, dev) != hipSuccess) { grid = -1; return; }
        if (hipFuncSetAttribute((const void*)skel_fwd, hipFuncAttributeMaxDynamicSharedMemorySize, LDS_BYTES) != hipSuccess) { fprintf(stderr, "kernel_launch: hipFuncSetAttribute failed\n"); grid = -1; return; }
        if (hipOccupancyMaxActiveBlocksPerMultiprocessor(&per_cu, (const void*)skel_fwd, NWAVES * 64, LDS_BYTES) != hipSuccess || per_cu < 1) { fprintf(stderr, "kernel_launch: occupancy query says %d blocks/CU\n", per_cu); grid = -1; (void)hipGetLastError(); return; }
        grid = cus;
    }
    if (grid < 0) return;
    if (hipMemsetAsync((char*)d_ws + WS_CTL, 0, CTL_ZERO_BYTES, stream) != hipSuccess) return;
    Args a{};
    for (int i = 0; i < 22; ++i) a.in[i] = (const float*)d_in[i];
    a.out = (float*)d_out; a.ws = (unsigned char*)d_ws;
    unsigned char* ws = (unsigned char*)d_ws; float* out = (float*)d_out;
    const unsigned short* PROJ = (const unsigned short*)(ws + WS_PROJ);
    (void)out; (void)PROJ;
#if HYBRID >= 1
    for (int p = 0; p < N_PHASES; ++p) launch_phases(a, p, p + 1, 0, grid, stream);
#else
    launch_phases(a, 0, N_PHASES, 0, grid, stream);
#endif
}
```

```cpp
#include <hip/hip_runtime.h>
#include <cstdio>
#include <cstdint>
#include <cmath>
#define HYBRID 0
#define HYBRID_ML_NAIVE 0
#define HYBRID_SB_NAIVE 0
#define HYBRID_P5_NAIVE 0
#define HYBRID_P8_NAIVE 0
#define P8_DEBUG 0
#define REPEAT -1
namespace pg8 {
#define PG8_LAS __attribute__((address_space(3)))
typedef unsigned short bf16_t;
typedef short bf16x8 __attribute__((ext_vector_type(8)));
typedef float f32x4 __attribute__((ext_vector_type(4)));
typedef unsigned u32x4 __attribute__((ext_vector_type(4)));
constexpr int BM = 256, BK = 64, HALF = 128, HTB = HALF * BK * 2  , STAGE_BYTES = 8 * HTB, NXCD = 8, WGM = 8;

__host__ __device__ __forceinline__ int lds_byte(int r, int c) { const int st = (r >> 4) * 2 + (c >> 5), rr = r & 15, cc = c & 31, ob = rr * 64 + cc * 2; return st * 1024 + (ob ^ (((ob >> 9) & 1) << 5)); }
__host__ __device__ __forceinline__ void stage_rc(int b, int& R, int& C) { const int st = b / 1024, sb = b % 1024, swz = sb ^ (((sb >> 9) & 1) << 5); R = (st >> 1) * 16 + swz / 64; C = (st & 1) * 32 + (swz % 64) / 2; }
__host__ __device__ __forceinline__ int perm32(int rho) { const int n = rho >> 4, i = rho & 15; return 8 * (i >> 2) + 4 * n + (i & 3); }

struct Unit { int pm, pn; };
struct Gemm { const bf16_t* A; const bf16_t* Bt; int M, N, K; int bshift; size_t bstride; };

struct StaticOrder {
    int nM, nN, nwg, G, c;
    __host__ __device__ void init(int M, int N, int G_, int c_) { nM = M / BM; nN = N / BM; nwg = nM * nN; G = G_; c = c_; }
    __host__ __device__ bool next(int i, Unit& u) const {
        const long L = (long)i * G + c; if (L >= nwg) return false;
        int wgid = (int)L; { const int q = nwg / NXCD, r = nwg % NXCD, xcd = wgid % NXCD, off = wgid / NXCD; wgid = (xcd < r ? xcd * (q + 1) : r * (q + 1) + (xcd - r) * q) + off; }
        const int nig = WGM * nN, gid = wgid / nig, fm = gid * WGM, gsz = (nM - fm) < WGM ? (nM - fm) : WGM;
        u.pm = fm + ((wgid % nig) % gsz); u.pn = (wgid % nig) / gsz; return true;
    }
    __device__ __forceinline__ void a_ready(const Unit&) const {}
    __device__ __forceinline__ void done(const Unit&) const {}
};

__device__ __forceinline__ unsigned cvt_pk_bf16(float lo, float hi) { unsigned r; asm volatile("v_cvt_pk_bf16_f32 %0, %1, %2" : "=v"(r) : "v"(lo), "v"(hi)); return r; }
typedef float f32x2 __attribute__((ext_vector_type(2)));
typedef unsigned u32x2 __attribute__((ext_vector_type(2)));
typedef _Float16 f16x2 __attribute__((ext_vector_type(2)));
__device__ __forceinline__ float xadd16(float r) { float a = r, b = r; asm volatile("s_nop 1\n\tv_permlane16_swap_b32 %0, %1\n\ts_nop 1" : "+v"(a), "+v"(b)); return a + b; }
__device__ __forceinline__ float xadd32(float r) { float a = r, b = r; asm volatile("s_nop 1\n\tv_permlane32_swap_b32 %0, %1\n\ts_nop 1" : "+v"(a), "+v"(b)); return a + b; }
__device__ __forceinline__ float xmax32(float r) { float a = r, b = r; asm volatile("s_nop 1\n\tv_permlane32_swap_b32 %0, %1\n\ts_nop 1" : "+v"(a), "+v"(b)); return fmaxf(a, b); }
__device__ __forceinline__ float xmax16(float r) { float a = r, b = r; asm volatile("s_nop 1\n\tv_permlane16_swap_b32 %0, %1\n\ts_nop 1" : "+v"(a), "+v"(b)); return fmaxf(a, b); }
struct OneUnit {
    int pm, pn;
    __device__ __forceinline__ bool next(int i, Unit& u) const { if (i != 0) return false; u.pm = pm; u.pn = pn; return true; }
    __device__ __forceinline__ void a_ready(const Unit&) const {}
    __device__ __forceinline__ void done(const Unit&) const {}
};
template <bool F16> struct EpiRow {
    static constexpr bool PERM = true, AFTER_DRAIN = false;
    bf16_t* O; int ldc; const float* ssq; int nparts;
    __device__ __forceinline__ void operator()(const f32x4 (&acc)[2][2][4][2], const Unit& u, int wr, int wc, int fr, int fq) const {
        const int row0 = u.pm * BM + wr * 64 + fr; const int col0 = u.pn * BM + wc * 32 + 8 * fq;
        float scl[2][4];
#pragma unroll
        for (int ai = 0; ai < 2; ++ai)
#pragma unroll
            for (int m = 0; m < 4; ++m) scl[ai][m] = 1.0f;
        if (ssq) {
            if (nparts == 1) {
#pragma unroll
                for (int ai = 0; ai < 2; ++ai)
#pragma unroll
                    for (int m = 0; m < 4; ++m) scl[ai][m] = ssq[row0 + ai * HALF + m * 16];
            } else {
                { f32x4 qv[2][4];
#pragma unroll
                  for (int ai = 0; ai < 2; ++ai)
#pragma unroll
                    for (int m = 0; m < 4; ++m) qv[ai][m] = *((const f32x4*)(ssq + (size_t)(row0 + ai * HALF + m * 16) * 16) + fq);
#pragma unroll
                  for (int ai = 0; ai < 2; ++ai)
#pragma unroll
                    for (int m = 0; m < 4; ++m) { float t = (qv[ai][m][0] + qv[ai][m][1]) + (qv[ai][m][2] + qv[ai][m][3]); t = xadd16(t); t = xadd32(t); scl[ai][m] = t; } }
            }
#pragma unroll
            for (int ai = 0; ai < 2; ++ai)
#pragma unroll
                for (int m = 0; m < 4; ++m) scl[ai][m] = __builtin_amdgcn_rsqf(scl[ai][m] * (1.0f / 1024.0f) + 1e-6f);
        }
#pragma unroll
        for (int ai = 0; ai < 2; ++ai)
#pragma unroll
            for (int m = 0; m < 4; ++m) { const int row = row0 + ai * HALF + m * 16; bf16_t* rowp = O + (size_t)row * ldc + col0; const float sc = scl[ai][m];
#pragma unroll
                for (int bj = 0; bj < 2; ++bj) { const f32x4 v0 = acc[ai][bj][m][0] * sc, v1 = acc[ai][bj][m][1] * sc; u32x4 w;
                    if (F16) { w.x = __builtin_bit_cast(unsigned, __builtin_amdgcn_cvt_pkrtz(v0[0], v0[1])); w.y = __builtin_bit_cast(unsigned, __builtin_amdgcn_cvt_pkrtz(v0[2], v0[3]));
                               w.z = __builtin_bit_cast(unsigned, __builtin_amdgcn_cvt_pkrtz(v1[0], v1[1])); w.w = __builtin_bit_cast(unsigned, __builtin_amdgcn_cvt_pkrtz(v1[2], v1[3])); }
                    else { w.x = cvt_pk_bf16(v0[0], v0[1]); w.y = cvt_pk_bf16(v0[2], v0[3]); w.z = cvt_pk_bf16(v1[0], v1[1]); w.w = cvt_pk_bf16(v1[2], v1[3]); }
                    *(u32x4*)(rowp + bj * HALF) = w; } }
    }
};
template <bool RB16> struct EpiRes {
    static constexpr bool PERM = true, AFTER_DRAIN = false;
    const void* R; bf16_t* XB; float* ssq; int ldc;
    __device__ __forceinline__ void operator()(const f32x4 (&acc)[2][2][4][2], const Unit& u, int wr, int wc, int fr, int fq) const {
        const int col0 = u.pn * BM + wc * 32 + 8 * fq;
#pragma unroll
        for (int ai = 0; ai < 2; ++ai) {
            u32x4 rw[4][2];
#pragma unroll
            for (int m = 0; m < 4; ++m) { const int row = u.pm * BM + ai * HALF + wr * 64 + m * 16 + fr; const size_t off = (size_t)row * ldc + col0;
#pragma unroll
                for (int bj = 0; bj < 2; ++bj) rw[m][bj] = *(const u32x4*)((const bf16_t*)R + off + bj * HALF); }
#pragma unroll
            for (int m = 0; m < 4; ++m) { const int row = u.pm * BM + ai * HALF + wr * 64 + m * 16 + fr; const size_t off = (size_t)row * ldc + col0; float s = 0.f;
#pragma unroll
                for (int bj = 0; bj < 2; ++bj) { const size_t o2 = off + bj * HALF; const u32x4 w_ = rw[m][bj];
                    const f32x4 r0 = (f32x4){__builtin_bit_cast(float, w_.x << 16), __builtin_bit_cast(float, w_.x & 0xFFFF0000u), __builtin_bit_cast(float, w_.y << 16), __builtin_bit_cast(float, w_.y & 0xFFFF0000u)};
                    const f32x4 r1 = (f32x4){__builtin_bit_cast(float, w_.z << 16), __builtin_bit_cast(float, w_.z & 0xFFFF0000u), __builtin_bit_cast(float, w_.w << 16), __builtin_bit_cast(float, w_.w & 0xFFFF0000u)};
                    const f32x4 x0 = r0 + acc[ai][bj][m][0], x1 = r1 + acc[ai][bj][m][1];
                    u32x4 w; w.x = cvt_pk_bf16(x0[0], x0[1]); w.y = cvt_pk_bf16(x0[2], x0[3]); w.z = cvt_pk_bf16(x1[0], x1[1]); w.w = cvt_pk_bf16(x1[2], x1[3]); *(u32x4*)(XB + o2) = w;
#pragma unroll
                    for (int k = 0; k < 4; ++k) { const float lo = __builtin_bit_cast(float, w[k] << 16), hi = __builtin_bit_cast(float, w[k] & 0xFFFF0000u); s += lo * lo + hi * hi; } }
                s = xadd16(s); s = xadd32(s);
                if (fq == 0) ssq[(size_t)row * 16 + u.pn * 4 + wc] = s; }
        }
    }
};
struct EpiBlk {
    static constexpr bool PERM = true, AFTER_DRAIN = false;
    bf16_t* O; int nbn;
    __device__ __forceinline__ void operator()(const f32x4 (&acc)[2][2][4][2], const Unit& u, int wr, int wc, int fr, int fq) const {
        bf16_t* blk = O + (size_t)(u.pm * nbn + u.pn) * (BM * BM);
        const int row0 = wr * 64 + fr, col0 = wc * 32 + 8 * fq;
#pragma unroll
        for (int ai = 0; ai < 2; ++ai)
#pragma unroll
            for (int m = 0; m < 4; ++m) { bf16_t* rowp = blk + (size_t)(row0 + ai * HALF + m * 16) * BM + col0;
#pragma unroll
                for (int bj = 0; bj < 2; ++bj) { const f32x4 v0 = acc[ai][bj][m][0], v1 = acc[ai][bj][m][1]; u32x4 w;
                    w.x = cvt_pk_bf16(v0[0], v0[1]); w.y = cvt_pk_bf16(v0[2], v0[3]); w.z = cvt_pk_bf16(v1[0], v1[1]); w.w = cvt_pk_bf16(v1[2], v1[3]);
                    *(u32x4*)(rowp + bj * HALF) = w; } }
    }
};
struct EpiSoftmax {
    static constexpr bool PERM = true, AFTER_DRAIN = false;
    bf16_t* O; int ldc; const float* ssq; PG8_LAS float* ex;
    __device__ __forceinline__ void operator()(const f32x4 (&acc)[2][2][4][2], const Unit& u, int wr, int wc, int fr, int fq) const {
        float scl[2][4];
        { f32x4 qv[2][4];
#pragma unroll
          for (int ai = 0; ai < 2; ++ai)
#pragma unroll
            for (int m = 0; m < 4; ++m) qv[ai][m] = *((const f32x4*)(ssq + (size_t)(u.pm * BM + wr * 64 + fr + ai * HALF + m * 16) * 16) + fq);
#pragma unroll
          for (int ai = 0; ai < 2; ++ai)
#pragma unroll
            for (int m = 0; m < 4; ++m) { float t = (qv[ai][m][0] + qv[ai][m][1]) + (qv[ai][m][2] + qv[ai][m][3]); t = xadd16(t); t = xadd32(t); scl[ai][m] = __builtin_amdgcn_rsqf(t * (1.0f / 1024.0f) + 1e-6f); } }
#pragma unroll
        for (int ai = 0; ai < 2; ++ai)
#pragma unroll
            for (int m = 0; m < 4; ++m) { const int rl = wr * 64 + fr + ai * HALF + m * 16; const float s = scl[ai][m];
                float mx = -3.0e38f;
#pragma unroll
                for (int bj = 0; bj < 2; ++bj)
#pragma unroll
                    for (int n = 0; n < 2; ++n) { const f32x4 v = acc[ai][bj][m][n] * s; mx = fmaxf(mx, fmaxf(fmaxf(v[0], v[1]), fmaxf(v[2], v[3]))); }
                mx = xmax16(mx); mx = xmax32(mx);
                float l = 0.f;
#pragma unroll
                for (int bj = 0; bj < 2; ++bj)
#pragma unroll
                    for (int n = 0; n < 2; ++n) { const f32x4 v = acc[ai][bj][m][n] * s;
                        l += (__builtin_amdgcn_exp2f(v[0] - mx) + __builtin_amdgcn_exp2f(v[1] - mx)) + (__builtin_amdgcn_exp2f(v[2] - mx) + __builtin_amdgcn_exp2f(v[3] - mx)); }
                l = xadd16(l); l = xadd32(l);
                if (fq == 0) { ex[wc * 256 + rl] = mx; ex[1024 + wc * 256 + rl] = l; } }
        asm volatile("s_waitcnt lgkmcnt(0)" ::: "memory");
        __builtin_amdgcn_s_barrier();
#pragma unroll
        for (int ai = 0; ai < 2; ++ai)
#pragma unroll
            for (int m = 0; m < 4; ++m) { const int rl = wr * 64 + fr + ai * HALF + m * 16; const int row = u.pm * BM + rl;
                const float m0 = ex[rl], m1 = ex[256 + rl], m2 = ex[512 + rl], m3 = ex[768 + rl], l0 = ex[1024 + rl], l1 = ex[1280 + rl], l2 = ex[1536 + rl], l3 = ex[1792 + rl];
                const float M = fmaxf(fmaxf(m0, m1), fmaxf(m2, m3));
                const float L = (l0 * __builtin_amdgcn_exp2f(m0 - M) + l1 * __builtin_amdgcn_exp2f(m1 - M)) + (l2 * __builtin_amdgcn_exp2f(m2 - M) + l3 * __builtin_amdgcn_exp2f(m3 - M));
                const float inv = __builtin_amdgcn_rcpf(L), s = scl[ai][m];
                bf16_t* rowp = O + (size_t)row * ldc + u.pn * BM + wc * 32 + 8 * fq;
#pragma unroll
                for (int bj = 0; bj < 2; ++bj) { const f32x4 v0 = acc[ai][bj][m][0] * s, v1 = acc[ai][bj][m][1] * s; u32x4 w;
                    const float p0 = __builtin_amdgcn_exp2f(v0[0] - M) * inv, p1 = __builtin_amdgcn_exp2f(v0[1] - M) * inv, p2 = __builtin_amdgcn_exp2f(v0[2] - M) * inv, p3 = __builtin_amdgcn_exp2f(v0[3] - M) * inv;
                    const float p4 = __builtin_amdgcn_exp2f(v1[0] - M) * inv, p5 = __builtin_amdgcn_exp2f(v1[1] - M) * inv, p6 = __builtin_amdgcn_exp2f(v1[2] - M) * inv, p7 = __builtin_amdgcn_exp2f(v1[3] - M) * inv;
                    w.x = cvt_pk_bf16(p0, p1); w.y = cvt_pk_bf16(p2, p3); w.z = cvt_pk_bf16(p4, p5); w.w = cvt_pk_bf16(p6, p7);
                    *(u32x4*)(rowp + bj * HALF) = w; } }
        asm volatile("s_waitcnt lgkmcnt(0)" ::: "memory");
        __builtin_amdgcn_s_barrier();
    }
};
template <class Epi, class Sched, bool ALIGN_EPI = false, bool SP2 = false>
__device__ __forceinline__ void gemm_phase(PG8_LAS unsigned char* lds, const Gemm g, const Sched& S, const Epi& E) {
    int tid_ = threadIdx.x; asm volatile("" : "+v"(tid_));
    const int tid = tid_, wid = __builtin_amdgcn_readfirstlane(tid >> 6), lane = tid & 63, wr = wid >> 2, wc = wid & 3, fr = lane & 15, fq = lane >> 4;
    const int K = g.K, nt = K / BK;
    unsigned voffA[2], voffB[2];
#pragma unroll
    for (int i = 0; i < 2; ++i) { int R, C; stage_rc(tid * 16 + i * 8192, R, C); const int Rb = Epi::PERM ? ((R & ~31) + perm32(R & 31)) : R;
        voffA[i] = (unsigned)(R * K + C) * 2u; voffB[i] = (unsigned)(Rb * K + C) * 2u; }
    const size_t kstep = (size_t)(BK * 2);
    const size_t hstep = (size_t)HALF * K * 2;
    const size_t tstep = 2 * hstep;
    const unsigned ldsw = (unsigned)wid * 1024u;
    const int aoff = lds_byte(wr * 64 + fr, fq * 8), boff = lds_byte(wc * 32 + fr, fq * 8);
#define PG8_SA(b, h) (((b) * 2 + (h)) * HTB)
#define PG8_SB(b, h) ((4 + (b) * 2 + (h)) * HTB)
#define PG8_STAGE(bufoff, gbase, voff) do { _Pragma("unroll") for (int _i = 0; _i < 2; ++_i) \
        __builtin_amdgcn_global_load_lds((const unsigned*)((const char*)(gbase) + (voff)[_i]), (PG8_LAS unsigned*)(lds + (bufoff) + ldsw + _i * 8192), 16, 0, 0); } while (0)
#define PG8_LDA(dst, b, h) do { _Pragma("unroll") for (int m = 0; m < 4; ++m) _Pragma("unroll") for (int k = 0; k < 2; ++k) dst[m][k] = *(const PG8_LAS bf16x8*)(lds + PG8_SA(b, h) + aoff + m * 2048 + k * 1024); } while (0)
#define PG8_LDB(dst, b, h) do { _Pragma("unroll") for (int n = 0; n < 2; ++n) _Pragma("unroll") for (int k = 0; k < 2; ++k) dst[n][k] = *(const PG8_LAS bf16x8*)(lds + PG8_SB(b, h) + boff + n * 2048 + k * 1024); } while (0)
#define PG8_MMA(ai, bj, At, Bt) do { __builtin_amdgcn_s_setprio(1); _Pragma("unroll") for (int m = 0; m < 4; ++m) _Pragma("unroll") for (int n = 0; n < 2; ++n) _Pragma("unroll") for (int k = 0; k < 2; ++k) \
        acc[ai][bj][m][n] = __builtin_amdgcn_mfma_f32_16x16x32_bf16(Bt[n][k], At[m][k], acc[ai][bj][m][n], 0, 0, 0); __builtin_amdgcn_s_setprio(0); } while (0)
#define PG8_WAIT_V(n) asm volatile("s_waitcnt vmcnt(" #n ")" ::: "memory")
#define PG8_WAIT_L(n) asm volatile("s_waitcnt lgkmcnt(" #n ")" ::: "memory")
#define PG8_BAR __builtin_amdgcn_s_barrier()
#define PG8_SCHED __builtin_amdgcn_sched_barrier(0)
    Unit cur, nxt; int ui = 0;
    if (!S.next(0, cur)) return;
    f32x4 acc[2][2][4][2];
#pragma unroll
    for (int a = 0; a < 2; ++a)
#pragma unroll
        for (int b = 0; b < 2; ++b)
#pragma unroll
            for (int m = 0; m < 4; ++m)
#pragma unroll
                for (int n = 0; n < 2; ++n) acc[a][b][m][n] = (f32x4){0.f, 0.f, 0.f, 0.f};
    bf16x8 At[4][2], B0[2][2], B1[2][2];
    const char* cA = (const char*)g.A + (size_t)cur.pm * tstep; const char* cB = (const char*)g.Bt + (size_t)cur.pn * tstep + (size_t)(cur.pm >> g.bshift) * g.bstride;
    S.a_ready(cur);
    if constexpr (SP2) {
        PG8_STAGE(PG8_SB(0, 0), cB, voffB); PG8_STAGE(PG8_SB(0, 1), cB + hstep, voffB); PG8_STAGE(PG8_SA(0, 0), cA, voffA); PG8_STAGE(PG8_SA(0, 1), cA + hstep, voffA);
        if (wr == 1) PG8_BAR;
        PG8_WAIT_V(2); PG8_BAR;
        PG8_STAGE(PG8_SB(1, 0), cB + kstep, voffB); PG8_STAGE(PG8_SA(1, 0), cA + kstep, voffA); PG8_STAGE(PG8_SB(1, 1), cB + hstep + kstep, voffB);
        PG8_WAIT_V(6); PG8_BAR;
    } else {
        PG8_STAGE(PG8_SB(0, 0), cB, voffB); PG8_STAGE(PG8_SA(0, 0), cA, voffA); PG8_STAGE(PG8_SB(0, 1), cB + hstep, voffB); PG8_STAGE(PG8_SA(0, 1), cA + hstep, voffA);
        if (wr == 1) PG8_BAR;
        PG8_WAIT_V(4); PG8_BAR;
        PG8_STAGE(PG8_SB(1, 0), cB + kstep, voffB); PG8_STAGE(PG8_SA(1, 0), cA + kstep, voffA); PG8_STAGE(PG8_SB(1, 1), cB + hstep + kstep, voffB);
        PG8_WAIT_V(6); PG8_BAR;
    }
    for (;;) {
        const bool has_next = S.next(ui + 1, nxt);
        const char* nA = has_next ? (const char*)g.A + (size_t)nxt.pm * tstep : cA; const char* nB = has_next ? (const char*)g.Bt + (size_t)nxt.pn * tstep + (size_t)(nxt.pm >> g.bshift) * g.bstride : cB;
        for (int t = 0; t < nt; t += 2) {
            const bool last = (t == nt - 2);
            const char* a1 = cA + (size_t)(t + 1) * kstep;
            const char* a2 = last ? nA : cA + (size_t)(t + 2) * kstep; const char* b2 = last ? nB : cB + (size_t)(t + 2) * kstep;
            const char* a3 = a2 + kstep; const char* b3 = b2 + kstep;
            if (last && has_next) S.a_ready(nxt);
            if constexpr (SP2) {
            PG8_LDB(B0, 0, 0); PG8_LDB(B1, 0, 1); PG8_SCHED; PG8_LDA(At, 0, 0); PG8_STAGE(PG8_SA(1, 1), a1 + hstep, voffA);
            PG8_WAIT_V(8); PG8_WAIT_L(0); PG8_BAR; PG8_MMA(0, 0, At, B0); PG8_MMA(0, 1, At, B1); PG8_BAR; PG8_SCHED;
            PG8_LDA(At, 0, 1); PG8_STAGE(PG8_SB(0, 0), b2, voffB); PG8_STAGE(PG8_SB(0, 1), b2 + hstep, voffB); PG8_STAGE(PG8_SA(0, 0), a2, voffA);
            PG8_WAIT_V(8); PG8_WAIT_L(0); PG8_BAR; PG8_MMA(1, 0, At, B0); PG8_MMA(1, 1, At, B1); PG8_BAR; PG8_SCHED;
            PG8_LDB(B0, 1, 0); PG8_LDB(B1, 1, 1); PG8_SCHED; PG8_LDA(At, 1, 0); PG8_STAGE(PG8_SA(0, 1), a2 + hstep, voffA);
            PG8_WAIT_V(8); PG8_WAIT_L(0); PG8_BAR; PG8_MMA(0, 0, At, B0); PG8_MMA(0, 1, At, B1); PG8_BAR; PG8_SCHED;
            PG8_LDA(At, 1, 1); PG8_STAGE(PG8_SB(1, 0), b3, voffB); PG8_STAGE(PG8_SB(1, 1), b3 + hstep, voffB); PG8_STAGE(PG8_SA(1, 0), a3, voffA);
            PG8_WAIT_V(8); PG8_WAIT_L(0); PG8_BAR; PG8_MMA(1, 0, At, B0); PG8_MMA(1, 1, At, B1); PG8_BAR; PG8_SCHED;
            } else {
            PG8_LDB(B0, 0, 0); PG8_SCHED; PG8_LDA(At, 0, 0); PG8_STAGE(PG8_SA(1, 1), a1 + hstep, voffA);
            PG8_WAIT_L(8); PG8_BAR; PG8_WAIT_L(0); PG8_MMA(0, 0, At, B0); PG8_BAR; PG8_SCHED;
            PG8_LDB(B1, 0, 1); PG8_STAGE(PG8_SB(0, 0), b2, voffB);
            PG8_BAR; PG8_WAIT_L(0); PG8_MMA(0, 1, At, B1); PG8_BAR;
            PG8_LDA(At, 0, 1); PG8_STAGE(PG8_SA(0, 0), a2, voffA);
            PG8_BAR; PG8_WAIT_L(0); PG8_MMA(1, 0, At, B0); PG8_BAR; PG8_SCHED;
            PG8_STAGE(PG8_SB(0, 1), b2 + hstep, voffB);
            PG8_WAIT_V(6); PG8_BAR; PG8_MMA(1, 1, At, B1); PG8_BAR;
            PG8_LDB(B0, 1, 0); PG8_SCHED; PG8_LDA(At, 1, 0); PG8_STAGE(PG8_SA(0, 1), a2 + hstep, voffA);
            PG8_WAIT_L(8); PG8_BAR; PG8_WAIT_L(0); PG8_MMA(0, 0, At, B0); PG8_BAR; PG8_SCHED;
            PG8_LDB(B1, 1, 1); PG8_STAGE(PG8_SB(1, 0), b3, voffB);
            PG8_BAR; PG8_WAIT_L(0); PG8_MMA(0, 1, At, B1); PG8_BAR;
            PG8_LDA(At, 1, 1); PG8_STAGE(PG8_SA(1, 0), a3, voffA);
            PG8_BAR; PG8_WAIT_L(0); PG8_MMA(1, 0, At, B0); PG8_BAR; PG8_SCHED;
            PG8_STAGE(PG8_SB(1, 1), b3 + hstep, voffB);
            PG8_WAIT_V(6); PG8_BAR; PG8_MMA(1, 1, At, B1); PG8_BAR;
            }
        }
        if constexpr (ALIGN_EPI) { if (wr == 0) PG8_BAR; }
        if constexpr (!Epi::AFTER_DRAIN) { E(acc, cur, wr, wc, fr, fq); S.done(cur); }
        if (!has_next) break;
#pragma unroll
        for (int a = 0; a < 2; ++a)
#pragma unroll
            for (int b = 0; b < 2; ++b)
#pragma unroll
                for (int m = 0; m < 4; ++m)
#pragma unroll
                    for (int n = 0; n < 2; ++n) acc[a][b][m][n] = (f32x4){0.f, 0.f, 0.f, 0.f};
        cur = nxt; cA = nA; cB = nB; ++ui;
        if constexpr (ALIGN_EPI) { if (wr == 1) PG8_BAR; }
    }
    PG8_WAIT_V(0);
    if constexpr (!ALIGN_EPI) { if (wr == 0) PG8_BAR; }
    PG8_BAR;
    if constexpr (Epi::AFTER_DRAIN) { E.fused(acc, cur, wr, wc, fr, fq, lds, wid, lane); S.done(cur); }
#undef PG8_SA
#undef PG8_SB
#undef PG8_STAGE
#undef PG8_LDA
#undef PG8_LDB
#undef PG8_MMA
#undef PG8_WAIT_V
#undef PG8_WAIT_L
#undef PG8_BAR
#undef PG8_SCHED
}
}
#define GAS __attribute__((address_space(1)))
#define LAS __attribute__((address_space(3)))
typedef unsigned short bf16;
typedef unsigned v4u __attribute__((ext_vector_type(4)));
typedef float f32x4 __attribute__((ext_vector_type(4)));
typedef short bf16x8 __attribute__((ext_vector_type(8)));
typedef GAS unsigned gu32;
typedef GAS unsigned long long gu64;
#define RLX_AGENT __ATOMIC_RELAXED, __HIP_MEMORY_SCOPE_AGENT
#define LDS_WAIT() asm volatile("s_waitcnt lgkmcnt(0)" ::: "memory")
#define VM_WAIT() asm volatile("s_waitcnt vmcnt(0)" ::: "memory")
__device__ __forceinline__ unsigned long long rt() { return __builtin_amdgcn_s_memrealtime(); }
__device__ __forceinline__ unsigned f2bf(float f) { unsigned u = __builtin_bit_cast(unsigned, f); return (u + 0x7fffu + ((u >> 16) & 1u)) >> 16; }
__device__ __forceinline__ unsigned pk2(float lo, float hi) { return f2bf(lo) | (f2bf(hi) << 16); }
#define XB_TMO      128
#define XB_XCNT(j)  (256  + 64 * (j))
#define XB_XSUB(j)  (1280 + 64 * (j))
#define XB_XGEN(j)  (2304 + 64 * (j))
#define XB_TOP      3328
#define XB_TOPGEN   3392
#define XCD_BAR_WORDS 3456
#define XB_SPIN_CAP (1u << 18)

__device__ __forceinline__ unsigned xb_ld(unsigned* p)              { return __hip_atomic_load(p, __ATOMIC_RELAXED, __HIP_MEMORY_SCOPE_AGENT); }
__device__ __forceinline__ unsigned xb_add(unsigned* p, unsigned v) { return __hip_atomic_fetch_add(p, v, __ATOMIC_RELAXED, __HIP_MEMORY_SCOPE_AGENT); }
__device__ __forceinline__ unsigned xb_xcc_id() { return (unsigned)__builtin_amdgcn_s_getreg((3 << 11) | 20) & 0xFu; }
#define XB_SPIN(cond, bar) do { unsigned _sp = 0; while (cond) { __builtin_amdgcn_s_sleep(1); \
    if ((++_sp & 255u) == 0u) { if (xb_ld(&(bar)[XB_TMO])) break; if (_sp > XB_SPIN_CAP) { atomicAdd(&(bar)[XB_TMO], 1u); break; } } } } while (0)

struct XcdBarrier {
    unsigned* bar; unsigned x;
    volatile LAS unsigned* st;
};

__device__ __forceinline__ XcdBarrier xcd_barrier_post(unsigned* bar, volatile LAS unsigned* st) {
    XcdBarrier b; b.bar = bar; b.x = xb_xcc_id(); b.st = st;
    if (threadIdx.x == 0) (void)xb_add(&bar[XB_XCNT(b.x)], 1u);
    return b;
}
__device__ __forceinline__ void xcd_barrier_complete(unsigned* bar, unsigned x, unsigned& nloc, unsigned& nx) {
    const unsigned G = gridDim.x * gridDim.y * gridDim.z;
    unsigned sum, cnt, mine, sp = 0u;
    for (;;) {
        sum = 0u; cnt = 0u; mine = 0u;
#pragma unroll
        for (unsigned j = 0; j < 16; ++j) { const unsigned c = xb_ld(&bar[XB_XCNT(j)]); sum += c; cnt += (c > 0u) ? 1u : 0u; mine = (j == x) ? c : mine; }
        if (sum == G) break;
        __builtin_amdgcn_s_sleep(1);
        if ((++sp & 255u) == 0u) { if (xb_ld(&bar[XB_TMO])) break; if (sp > XB_SPIN_CAP) { atomicAdd(&bar[XB_TMO], 1u); break; } }
    }
    nloc = mine > 0u ? mine : 1u; nx = cnt > 0u ? cnt : 1u;
}

__device__ __forceinline__ void xcd_barrier(const XcdBarrier& b) {
    asm volatile("s_waitcnt vmcnt(0)" ::: "memory");
    __syncthreads();
    if (threadIdx.x == 0) {
        unsigned* bar = b.bar;
        __builtin_amdgcn_s_waitcnt(0);
        unsigned nloc = b.st[0], nx = b.st[1];
        if (nloc == 0u) { xcd_barrier_complete(bar, b.x, nloc, nx); b.st[0] = nloc; b.st[1] = nx; }
        const unsigned old = xb_add(&bar[XB_XSUB(b.x)], 1u);
        const unsigned gen = old / nloc;
        if (old + 1u == (gen + 1u) * nloc) {
            __builtin_amdgcn_fence(__ATOMIC_RELEASE, "agent");
            asm volatile("s_waitcnt vmcnt(0)" ::: "memory");
            const unsigned og = xb_add(&bar[XB_TOP], 1u);
            const unsigned tg = og / nx;
            if (og + 1u == (tg + 1u) * nx) xb_add(&bar[XB_TOPGEN], 1u);
            else XB_SPIN(xb_ld(&bar[XB_TOPGEN]) == tg, bar);
            __builtin_amdgcn_fence(__ATOMIC_ACQUIRE, "agent");
            xb_add(&bar[XB_XGEN(b.x)], 1u);
            asm volatile("s_waitcnt vmcnt(0)" ::: "memory");
        } else {
            XB_SPIN(xb_ld(&bar[XB_XGEN(b.x)]) == gen, bar);
            __builtin_amdgcn_fence(__ATOMIC_ACQUIRE, "agent");
            asm volatile("s_waitcnt vmcnt(0)" ::: "memory");
        }
    }
    __syncthreads();
}

typedef float f32x16 __attribute__((ext_vector_type(16)));
typedef short v4i16_t __attribute__((ext_vector_type(4)));
typedef float f32x2_t __attribute__((ext_vector_type(2)));
typedef __bf16 bf16x2_t __attribute__((ext_vector_type(2)));
#define DI __device__ __forceinline__
#define MFMA32(a, b, c) __builtin_amdgcn_mfma_f32_32x32x16_bf16((a), (b), (c), 0, 0, 0)
DI int crow(int r, int h) { return (r & 3) + 8 * (r >> 2) + 4 * h; }
DI unsigned cvtpk(float lo, float hi) { f32x2_t v = {lo, hi}; bf16x2_t b = __builtin_convertvector(v, bf16x2_t); return __builtin_bit_cast(unsigned, b); }
template <int S8> DI bf16x8 pack8(const f32x16& x) { v4u p; p.x = cvtpk(x[8 * S8], x[8 * S8 + 1]); p.y = cvtpk(x[8 * S8 + 2], x[8 * S8 + 3]); p.z = cvtpk(x[8 * S8 + 4], x[8 * S8 + 5]); p.w = cvtpk(x[8 * S8 + 6], x[8 * S8 + 7]); return __builtin_bit_cast(bf16x8, p); }
DI v4i16_t tr16(const LAS unsigned char* p) { return __builtin_amdgcn_ds_read_tr16_b64_v4i16((LAS v4i16_t*)p); }
DI bf16x8 tr_frag(const LAS unsigned char* p, int stride) { const v4i16_t lo = tr16(p), hi = tr16(p + 8 * stride); return (bf16x8){lo[0], lo[1], lo[2], lo[3], hi[0], hi[1], hi[2], hi[3]}; }
DI int tr_base(int lane, int stride) { const int i = lane & 15, g = lane >> 4; return (4 * (g >> 1) + (i >> 2)) * stride + (16 * (g & 1) + 4 * (i & 3)) * 2; }
DI bf16x8 tr_frag_nat(const LAS unsigned char* p, int stride) { const v4i16_t lo = tr16(p), hi = tr16(p + 4 * stride); return (bf16x8){lo[0], lo[1], lo[2], lo[3], hi[0], hi[1], hi[2], hi[3]}; }
DI int tr_base_nat(int lane, int stride) { const int i = lane & 15, g = lane >> 4; return (8 * (g >> 1) + (i >> 2)) * stride + (16 * (g & 1) + 4 * (i & 3)) * 2; }
template <int NCH> DI int swz_off(int r, int c) { return r * (NCH * 16) + ((c ^ (r & (NCH >= 16 ? 15 : 7))) << 4); }
#define DPP_U(x, ctrl) ((unsigned)__builtin_amdgcn_update_dpp(0, (int)(x), (ctrl), 0xf, 0xf, false))
#define DPP_F(x, ctrl) __builtin_bit_cast(float, __builtin_amdgcn_update_dpp(0, __builtin_bit_cast(int, (float)(x)), (ctrl), 0xf, 0xf, false))
__device__ __forceinline__ unsigned row_max_u(unsigned m) {
    m = max(m, DPP_U(m, 0xB1)); m = max(m, DPP_U(m, 0x4E)); m = max(m, DPP_U(m, 0x141)); m = max(m, DPP_U(m, 0x140)); return m;
}
__device__ __forceinline__ float row_sum_f(float s) {
    s += DPP_F(s, 0xB1); s += DPP_F(s, 0x4E); s += DPP_F(s, 0x141); s += DPP_F(s, 0x140); return s;
}
using pg8::xadd16; using pg8::xadd32; using pg8::xmax32;
__device__ __forceinline__ float wave_sum_dpp(float s) { s = row_sum_f(s); s = xadd16(s); s = xadd32(s); return s; }
__device__ __forceinline__ float bf_lo(unsigned w) { return __builtin_bit_cast(float, w << 16); }
__device__ __forceinline__ float bf_hi(unsigned w) { return __builtin_bit_cast(float, w & 0xFFFF0000u); }
constexpr int NWAVES = 8;
constexpr int T = 32768, D = 1024, SEQ = 4096, NBATCH = 8, PROJ_W = 3592, PROJ_N = 3584;
constexpr float EPS = 1e-6f, LOG2E = 1.4426950408889634f, LN2 = 0.6931471805599453f;
constexpr int PC_QM = 0, PC_KM = 512, PC_VM = 1024, PC_OM = 1536, PC_QS = 2048, PC_KS = 2560, PC_VS = 3072;
constexpr size_t MiB = 1u << 20;
constexpr size_t WS_CTL = 0, CTL_ZERO_BYTES = 1 * MiB;
constexpr size_t WS_SSQ0 = 1 * MiB, WS_GATES = 2 * MiB, WS_SSQ1 = 74 * MiB, WS_SSQ2 = 76 * MiB;
constexpr size_t WS_WIN = 4 * MiB, WS_WOUT = 11 * MiB, WS_WQ = 13 * MiB, WS_WKV = 15 * MiB, WS_WO = 19 * MiB, WS_WPS = 21 * MiB;
constexpr size_t WS_MEMN = 26 * MiB, WS_KVX = 30 * MiB;
constexpr size_t WS_M1 = 78 * MiB, WS_M2 = 460 * MiB;
constexpr size_t WS_UB = 40 * MiB, WS_USC = 72 * MiB;
constexpr size_t WS_XB = 104 * MiB;
constexpr size_t WS_MIX = 168 * MiB;
constexpr size_t WS_PROJ = 232 * MiB;
constexpr size_t WS_OX = 232 * MiB, WS_SC = 296 * MiB;
constexpr size_t WS_SCR = 456 * MiB, WS_END = 512 * MiB;
constexpr int CW_BAR = 4096;
constexpr int RING_BYTES = 131072, LDSCTL_OFF = 147456, MISC_OFF = LDSCTL_OFF + 320, LDS_BYTES = 151552;

typedef _Float16 h32 __attribute__((ext_vector_type(32)));
typedef float f32x32 __attribute__((ext_vector_type(32)));
typedef unsigned u32x6 __attribute__((ext_vector_type(6)));
typedef unsigned u32x2f __attribute__((ext_vector_type(2)));
struct Frame {
    LAS unsigned char* lds;
    volatile LAS unsigned* MISC;
    gu32* ctl;
    int tid, lane, wave, vcu, G;
    const float* in[22];
    float* out; unsigned char* ws;
};
enum { I_X = 0, I_MEM, I_MIXG, I_WIN, I_CONVW, I_CONVB, I_IGB, I_FGB, I_MNG, I_SNG, I_WOUT, I_XNG, I_MEMG, I_WQ, I_WKV, I_WO, I_FFNG, I_PWQ, I_PSK, I_PU, I_PV, I_FING };

__device__ __forceinline__ float wave_sum(float v) {
#pragma unroll
    for (int o = 1; o < 64; o <<= 1) v += __shfl_xor(v, o);
    return v;
}
__device__ __forceinline__ float log_sigmoid_f(float x) { return fminf(x, 0.f) - log1pf(expf(-fabsf(x))); }

template <bool BLK = false> __device__ __forceinline__ void p0_transpose_item(const float* W, int ldw, int K, int ncols, bf16* WT, int row_off, LAS float* scr, int item, int lane, const float* gk, float sc) {
    const int nblk = ncols / 32, kb = item / nblk, nb = item % nblk, k0 = 64 * kb, n0 = 32 * nb;
    const int r8 = lane >> 3, c4 = lane & 7;
    f32x4 w[8];
#pragma unroll
    for (int i = 0; i < 8; ++i) w[i] = __builtin_nontemporal_load((const GAS f32x4*)(W + (size_t)(k0 + r8 + 8 * i) * ldw + n0 + 4 * c4));
#pragma unroll
    for (int i = 0; i < 8; ++i) { const int kk = r8 + 8 * i; const float g = (gk ? gk[k0 + kk] : 1.0f) * sc; LAS float* d = scr + kk * 33 + 4 * c4;
        d[0] = w[i].x * g; d[1] = w[i].y * g; d[2] = w[i].z * g; d[3] = w[i].w * g; }
    LDS_WAIT(); asm volatile("" ::: "memory");
    const int c = lane & 7;
#pragma unroll
    for (int j = 0; j < 4; ++j) { const int n = (lane >> 3) + 8 * j; const LAS float* s = scr + (8 * c) * 33 + n;
        v4u o; o.x = cvtpk(s[0 * 33], s[1 * 33]); o.y = cvtpk(s[2 * 33], s[3 * 33]); o.z = cvtpk(s[4 * 33], s[5 * 33]); o.w = cvtpk(s[6 * 33], s[7 * 33]);
        if (BLK) *(GAS v4u*)(WT + ((size_t)(k0 >> 8) * ncols + n0 + n) * 256 + (k0 & 255) + 8 * c) = o;
        else *(GAS v4u*)(WT + (size_t)(row_off + n0 + n) * K + k0 + 8 * c) = o; }
    LDS_WAIT(); asm volatile("" ::: "memory");
}

__device__ __forceinline__ void p0_tr_a(Frame& F) {
    const int gw = F.vcu * NWAVES + F.wave, NGW = F.G * NWAVES;
    unsigned char* ws = F.ws;
    {
        LAS float* scr = (LAS float*)(F.lds + F.wave * 16384);
        constexpr int I_IN0 = 16 * (2048 / 32), I_IN1 = 16 * (512 / 32), I_IN2 = 16 * (1024 / 32), I_SQ = 16 * 32, I_KV = 16 * 64;
        constexpr int NITEMS = I_IN0 + I_IN1 + I_IN2 + 3 * I_SQ + I_KV;
        const float* win = F.in[I_WIN]; const float* mg = F.in[I_MIXG];
        for (int it = gw; it < NITEMS; it += NGW) {
            int r = it;
            if (r < I_IN0) { p0_transpose_item(win, PROJ_W, D, 2048, (bf16*)(ws + WS_WIN), 0, scr, r, F.lane, mg, 1.0f); continue; } r -= I_IN0;
            if (r < I_IN1) { p0_transpose_item(win + 2056, PROJ_W, D, 512, (bf16*)(ws + WS_WIN), 2048, scr, r, F.lane, mg, 0.125f * LOG2E); continue; } r -= I_IN1;
            if (r < I_IN2) { p0_transpose_item(win + 2568, PROJ_W, D, 1024, (bf16*)(ws + WS_WIN), 2560, scr, r, F.lane, mg, 1.0f); continue; } r -= I_IN2;
            if (r < I_SQ) { p0_transpose_item(F.in[I_WOUT], D, D, D, (bf16*)(ws + WS_WOUT), 0, scr, r, F.lane, nullptr, 1.0f); continue; } r -= I_SQ;
            if (r < I_SQ) {
#pragma unroll
                for (int rr = 0; rr < 2; ++rr) { const int k = 2 * r + rr; const float gsc = F.in[I_XNG][k] * (0.0625f * LOG2E); const GAS f32x4* src = (const GAS f32x4*)(F.in[I_WQ] + (size_t)k * D) + F.lane;
                    f32x4 v[4];
#pragma unroll
                    for (int j = 0; j < 4; ++j) v[j] = src[64 * j];
#pragma unroll
                    for (int j = 0; j < 4; ++j) { u32x2f o; o.x = cvtpk(v[j].x * gsc, v[j].y * gsc); o.y = cvtpk(v[j].z * gsc, v[j].w * gsc);
                        *(GAS u32x2f*)((bf16*)(ws + WS_WQ) + ((size_t)j * 1024 + k) * 256 + 4 * F.lane) = o; } }
                continue; } r -= I_SQ;
            if (r < I_SQ) { p0_transpose_item<true>(F.in[I_WO], D, D, D, (bf16*)(ws + WS_WO), 0, scr, r, F.lane, nullptr, 1.0f); continue; } r -= I_SQ;
            p0_transpose_item(F.in[I_WKV], 2048, D, 2048, (bf16*)(ws + WS_WKV), 0, scr, r, F.lane, nullptr, 1.0f);
        }
    }
}
__device__ __forceinline__ void p0_split8(const f32x4 x0, const f32x4 x1, bf16x8& hi, bf16x8& lo) {
    v4u h, l;
    h.x = cvtpk(x0.x, x0.y); h.y = cvtpk(x0.z, x0.w); h.z = cvtpk(x1.x, x1.y); h.w = cvtpk(x1.z, x1.w);
    l.x = cvtpk(x0.x - bf_lo(h.x), x0.y - bf_hi(h.x)); l.y = cvtpk(x0.z - bf_lo(h.y), x0.w - bf_hi(h.y));
    l.z = cvtpk(x1.x - bf_lo(h.z), x1.y - bf_hi(h.z)); l.w = cvtpk(x1.z - bf_lo(h.w), x1.w - bf_hi(h.w));
    hi = __builtin_bit_cast(bf16x8, h); lo = __builtin_bit_cast(bf16x8, l);
}
__device__ __forceinline__ void p0_fold_item(Frame& F, const int it) {
    unsigned char* ws = F.ws;
    const float* pwq = F.in[I_PWQ]; const float* psk = F.in[I_PSK]; const float* fg = F.in[I_FFNG];
    bf16* WPS = (bf16*)(ws + WS_WPS);
    const int mt = F.wave & 3, nt = F.wave >> 2, r32 = F.lane & 31, g = F.lane >> 5;
    {
        const int hp = it >> 4, k0 = (it & 15) * 64;
        const int n = mt * 32 + r32, k = k0 + nt * 32 + r32;
        const GAS f32x4* ap = (const GAS f32x4*)(psk + ((size_t)hp * 128 + n) * 128 + 8 * g);
        const GAS f32x4* bp = (const GAS f32x4*)(pwq + (size_t)k * 2048 + hp * 128 + 8 * g);
        f32x4 av[16], bv[16];
#pragma unroll
        for (int s = 0; s < 8; ++s) { av[2 * s] = ap[4 * s]; av[2 * s + 1] = ap[4 * s + 1]; bv[2 * s] = bp[4 * s]; bv[2 * s + 1] = bp[4 * s + 1]; }
        const float gk = fg[k];
        f32x16 acc;
#pragma unroll
        for (int r = 0; r < 16; ++r) acc[r] = 0.f;
#pragma unroll
        for (int s = 0; s < 8; ++s) { bf16x8 ah, al, bh, bl; p0_split8(av[2 * s], av[2 * s + 1], ah, al); p0_split8(bv[2 * s] * gk, bv[2 * s + 1] * gk, bh, bl);
            acc = MFMA32(ah, bh, acc); acc = MFMA32(ah, bl, acc); acc = MFMA32(al, bh, acc); }
#pragma unroll
        for (int r = 0; r < 16; ++r) WPS[((size_t)hp * 128 + mt * 32 + crow(r, g)) * D + k0 + nt * 32 + r32] = (bf16)(cvtpk(acc[r], 0.f) & 0xFFFFu);
    }
}
__device__ __forceinline__ void p0_rows_d(Frame& F) {
    const int gw = F.vcu * NWAVES + F.wave, NGW = F.G * NWAVES;
    unsigned char* ws = F.ws;
    const GAS f32x4* xbase = (const GAS f32x4*)F.in[I_X] + F.lane;
    f32x4 vn[4];
#pragma unroll
    for (int j = 0; j < 4; ++j) vn[j] = __builtin_nontemporal_load(xbase + (size_t)gw * 256 + 64 * j);
    LAS float* gwl = (LAS float*)F.lds;
    {
        f32x4 wv[4]; float mgv[4]; int tid_c = F.tid; asm volatile("" : "+v"(tid_c));
#pragma unroll
        for (int i = 0; i < 4; ++i) { const int id = tid_c + 512 * i, k = id >> 1, hf = id & 1; wv[i] = *(const GAS f32x4*)(F.in[I_WIN] + (size_t)k * PROJ_W + 2048 + 4 * hf); mgv[i] = F.in[I_MIXG][k]; }
#pragma unroll
        for (int i = 0; i < 4; ++i) { const int id = tid_c + 512 * i, k = id >> 1, hf = id & 1; LAS float* d = gwl + (4 * hf) * 1024 + k;
            d[0] = wv[i].x * mgv[i]; d[1024] = wv[i].y * mgv[i]; d[2048] = wv[i].z * mgv[i]; d[3072] = wv[i].w * mgv[i]; }
    }
    __syncthreads();
    {
        bf16* XB = (bf16*)(ws + WS_XB); float* ssq0 = (float*)(ws + WS_SSQ0); float* gates = (float*)(ws + WS_GATES);
        const float gbias = (F.lane < 4) ? F.in[I_IGB][F.lane & 3] : F.in[I_FGB][F.lane & 3];
        const int l15 = F.lane & 15;
        for (int m = gw; m < T; m += NGW) {
            f32x4 v[4];
#pragma unroll
            for (int j = 0; j < 4; ++j) v[j] = vn[j];
            const int mn = m + NGW;
            if (mn < T) {
#pragma unroll
                for (int j = 0; j < 4; ++j) vn[j] = __builtin_nontemporal_load(xbase + (size_t)mn * 256 + 64 * j); }
            float s = 0.f;
#pragma unroll
            for (int j = 0; j < 4; ++j) s += (v[j].x * v[j].x + v[j].y * v[j].y) + (v[j].z * v[j].z + v[j].w * v[j].w);
            GAS unsigned long long* o8 = (GAS unsigned long long*)(XB + (size_t)m * D) + F.lane;
#pragma unroll
            for (int j = 0; j < 4; ++j) o8[64 * j] = (unsigned long long)cvtpk(v[j].x, v[j].y) | ((unsigned long long)cvtpk(v[j].z, v[j].w) << 32);
            float t = row_sum_f(s);
#pragma unroll
            for (int g = 0; g < 8; ++g) { float d = 0.f;
#pragma unroll
                for (int j = 0; j < 4; ++j) { const f32x4 w = *(const LAS f32x4*)(gwl + g * 1024 + 4 * F.lane + 256 * j); d += (v[j].x * w.x + v[j].y * w.y) + (v[j].z * w.z + v[j].w * w.w); }
                d = row_sum_f(d); t = (l15 == g) ? d : t; }
            t = xadd16(t); t = xadd32(t);
            const float stot = __builtin_bit_cast(float, __builtin_amdgcn_readlane(__builtin_bit_cast(int, t), 8));
            const float r = rsqrtf(stot * (1.f / D) + EPS);
            if (F.lane == 8) ssq0[m] = t;
            if (F.lane < 8) { float pre = t * r; float val = (F.lane < 4) ? pre + gbias : log_sigmoid_f(pre + gbias); gates[(size_t)m * 8 + F.lane] = val; }
        }
    }
}
__device__ __forceinline__ void p0_rows_e(Frame& F) {
    const int gw = F.vcu * NWAVES + F.wave, NGW = F.G * NWAVES;
    unsigned char* ws = F.ws;
    {
        bf16* MEMN = (bf16*)(ws + WS_MEMN); const float* g = F.in[I_MEMG];
        for (int m = gw; m < 2048; m += NGW) {
            const GAS f32x4* xr = (const GAS f32x4*)(F.in[I_MEM] + (size_t)m * D) + F.lane;
            f32x4 v[4]; float s = 0.f;
#pragma unroll
            for (int j = 0; j < 4; ++j) { v[j] = xr[64 * j]; s += (v[j].x * v[j].x + v[j].y * v[j].y) + (v[j].z * v[j].z + v[j].w * v[j].w); }
            s = wave_sum(s);
            const float r = rsqrtf(s * (1.f / D) + EPS);
            GAS unsigned long long* o8 = (GAS unsigned long long*)(MEMN + (size_t)m * D) + F.lane;
#pragma unroll
            for (int j = 0; j < 4; ++j) { const f32x4 gg = *((const GAS f32x4*)g + F.lane + 64 * j);
                o8[64 * j] = (unsigned long long)cvtpk(v[j].x * r * gg.x, v[j].y * r * gg.y) | ((unsigned long long)cvtpk(v[j].z * r * gg.z, v[j].w * r * gg.w) << 32); }
        }
    }
}
__device__ __forceinline__ void p0_rows_f(Frame& F, const int gw, const int e_end, const int NGW) {
    unsigned char* ws = F.ws;
    {
        const GAS f32x4* pu_ = (const GAS f32x4*)F.in[I_PU] + F.lane; const GAS f32x4* pv_ = (const GAS f32x4*)F.in[I_PV] + F.lane;
        f32x4 un[4], wn[4];
        if (gw < e_end) {
#pragma unroll
            for (int j = 0; j < 4; ++j) { un[j] = __builtin_nontemporal_load(pu_ + (size_t)gw * 256 + 64 * j); wn[j] = __builtin_nontemporal_load(pv_ + (size_t)gw * 256 + 64 * j); } }
        for (int e = gw; e < e_end; e += NGW) {
            f32x4 u4[4], v4[4]; float mu = 0.f, mv = 0.f;
#pragma unroll
            for (int j = 0; j < 4; ++j) { u4[j] = un[j]; v4[j] = wn[j]; }
            const int en = e + NGW;
            if (en < e_end) {
#pragma unroll
                for (int j = 0; j < 4; ++j) { un[j] = __builtin_nontemporal_load(pu_ + (size_t)en * 256 + 64 * j); wn[j] = __builtin_nontemporal_load(pv_ + (size_t)en * 256 + 64 * j); } }
#pragma unroll
            for (int j = 0; j < 4; ++j) {
                mu = fmaxf(mu, fmaxf(fmaxf(fabsf(u4[j].x), fabsf(u4[j].y)), fmaxf(fabsf(u4[j].z), fabsf(u4[j].w))));
                mv = fmaxf(mv, fmaxf(fmaxf(fabsf(v4[j].x), fabsf(v4[j].y)), fmaxf(fabsf(v4[j].z), fabsf(v4[j].w)))); }
            { unsigned a_ = row_max_u(__builtin_bit_cast(unsigned, mu)), b_ = row_max_u(__builtin_bit_cast(unsigned, mv));
              a_ = max(a_, (unsigned)__shfl_xor((int)a_, 16)); b_ = max(b_, (unsigned)__shfl_xor((int)b_, 16));
              a_ = max(a_, (unsigned)__shfl_xor((int)a_, 32)); b_ = max(b_, (unsigned)__shfl_xor((int)b_, 32));
              mu = __builtin_bit_cast(float, a_); mv = __builtin_bit_cast(float, b_); }
            const float scu = (mu > 0.f) ? mu * (1.0f / 7.0f) : 1.0f, scv = (mv > 0.f) ? mv * (1.0f / 7.0f) : 1.0f, iu = 1.0f / scu, iv = 1.0f / scv;
            h32 hx;
#pragma unroll
            for (int j = 0; j < 4; ++j) { hx[4 * j] = (_Float16)(u4[j].x * iu); hx[4 * j + 1] = (_Float16)(u4[j].y * iu); hx[4 * j + 2] = (_Float16)(u4[j].z * iu); hx[4 * j + 3] = (_Float16)(u4[j].w * iu);
                hx[16 + 4 * j] = (_Float16)(v4[j].x * iv); hx[16 + 4 * j + 1] = (_Float16)(v4[j].y * iv); hx[16 + 4 * j + 2] = (_Float16)(v4[j].z * iv); hx[16 + 4 * j + 3] = (_Float16)(v4[j].w * iv); }
            const u32x6 p = __builtin_amdgcn_cvt_scalef32_pk32_fp6_f16(hx, 1.0f);
            unsigned char* dst = ws + WS_UB + (size_t)e * 1536;
            __builtin_nontemporal_store((v4u){p[0], p[1], p[2], p[3]}, (GAS v4u*)(dst + F.lane * 16)); __builtin_nontemporal_store((u32x2f){p[4], p[5]}, (GAS u32x2f*)(dst + 1024 + F.lane * 8));
            if (F.lane == 0) { ((float*)(ws + WS_USC))[2 * e] = scu; ((float*)(ws + WS_USC))[2 * e + 1] = scv; }
        }
    }
}
#ifndef REPEAT
#define REPEAT -1
#endif
#define P0_REP(k, call) call; if (REPEAT == (k)) { __syncthreads(); call; }
__device__ __forceinline__ void p0_prologue(Frame& F) {
    P0_REP(30, p0_tr_a(F))
    __syncthreads();
    P0_REP(32, p0_rows_d(F))
    P0_REP(33, p0_rows_e(F))
    P0_REP(34, p0_rows_f(F, F.vcu * NWAVES + F.wave, 16384, F.G * NWAVES))
}
constexpr int ML_Q = 0, ML_K = 32768, ML_C = 65536, ML_V = 98304, ML_VST = 320, ML_SM = ML_V + 128 * ML_VST;
constexpr int SM_A2 = 0, SM_M2 = 512, SM_EMT = 1024, SM_INTER = 1536, SM_WS = 2048, SM_NB = 3072, SM_SSQ = 3328, SM_SCAL = 4352;
constexpr size_t MLG_CLOC = 0, MLG_CST = 64 * MiB;
constexpr size_t MLG_NLOC = WS_SCR, MLG_NST = WS_SCR + 524288, MLG_SCAL = WS_SCR + 1048576, MLG_MST = MLG_SCAL + 8192;
typedef unsigned u32x2g __attribute__((ext_vector_type(2)));
template <bool IS_MAX> __device__ __forceinline__ float wave_scan_incl(float x, int lane) {
    const int idb = IS_MAX ? (int)0xFF800000u : 0;
#define SC_STEP_(ctrl) { const float y = __builtin_bit_cast(float, __builtin_amdgcn_update_dpp(idb, __builtin_bit_cast(int, x), ctrl, 0xf, 0xf, false)); x = IS_MAX ? fmaxf(x, y) : x + y; }
    SC_STEP_(0x111) SC_STEP_(0x112) SC_STEP_(0x114) SC_STEP_(0x118)
#undef SC_STEP_
    const float idf = __builtin_bit_cast(float, idb);
    const float t0 = __builtin_bit_cast(float, __builtin_amdgcn_readlane(__builtin_bit_cast(int, x), 15)), t1 = __builtin_bit_cast(float, __builtin_amdgcn_readlane(__builtin_bit_cast(int, x), 31)),
                t2 = __builtin_bit_cast(float, __builtin_amdgcn_readlane(__builtin_bit_cast(int, x), 47));
    const float p0 = (lane >= 16) ? t0 : idf, p1 = (lane >= 32) ? t1 : idf, p2 = (lane >= 48) ? t2 : idf;
    return IS_MAX ? fmaxf(fmaxf(x, p0), fmaxf(p1, p2)) : x + ((p0 + p1) + p2);
}
__device__ __forceinline__ float silu_f(float a) { return a * __builtin_amdgcn_rcpf(1.0f + __expf(-a)); }
__device__ __forceinline__ void ml_conv_load(const bf16* PROJ, size_t rowbase, int c, int h, int which, int tg, int cc, v4u (&raw)[7]) {
    const int pc = which ? PC_KM : PC_QM;
#pragma unroll
    for (int i = 0; i < 7; ++i) { const int tl = c * 128 + 4 * tg - 3 + i;
        raw[i] = (v4u){0u, 0u, 0u, 0u};
        if (tl >= 0) raw[i] = *(const GAS v4u*)(PROJ + (rowbase + tl) * PROJ_N + pc + h * 128 + 8 * cc); }
}
__device__ __forceinline__ void ml_conv_wload(Frame& F, int h, int which, int cc, f32x4 (&cw)[4][2], f32x4 (&cb)[2]) {
    const int ch0 = (which ? 512 : 0) + h * 128 + 8 * cc;
#pragma unroll
    for (int j = 0; j < 4; ++j) { cw[j][0] = *(const GAS f32x4*)(F.in[I_CONVW] + j * 1024 + ch0); cw[j][1] = *(const GAS f32x4*)(F.in[I_CONVW] + j * 1024 + ch0 + 4); }
    cb[0] = *(const GAS f32x4*)(F.in[I_CONVB] + ch0); cb[1] = *(const GAS f32x4*)(F.in[I_CONVB] + ch0 + 4);
}
__device__ __forceinline__ void ml_conv_apply(Frame& F, int which, int tg, int cc, const v4u (&raw)[7], const f32x4 (&cw4)[4][2], const f32x4 (&cb4)[2], LAS unsigned char* dstl) {
    const float osc = which ? 0.08838834764831845f : 1.0f;
    float cw[4][8], cb[8];
#pragma unroll
    for (int j = 0; j < 4; ++j) { cw[j][0] = cw4[j][0].x; cw[j][1] = cw4[j][0].y; cw[j][2] = cw4[j][0].z; cw[j][3] = cw4[j][0].w; cw[j][4] = cw4[j][1].x; cw[j][5] = cw4[j][1].y; cw[j][6] = cw4[j][1].z; cw[j][7] = cw4[j][1].w; }
    cb[0] = cb4[0].x; cb[1] = cb4[0].y; cb[2] = cb4[0].z; cb[3] = cb4[0].w; cb[4] = cb4[1].x; cb[5] = cb4[1].y; cb[6] = cb4[1].z; cb[7] = cb4[1].w;
#pragma unroll
    for (int tt = 0; tt < 4; ++tt) { float o[8];
#pragma unroll
        for (int e = 0; e < 8; ++e) { float a = cb[e];
#pragma unroll
            for (int j = 0; j < 4; ++j) a += cw[j][e] * ((e & 1) ? bf_hi(raw[tt + j][e >> 1]) : bf_lo(raw[tt + j][e >> 1]));
            o[e] = silu_f(a) * osc; }
        v4u pk; pk.x = cvtpk(o[0], o[1]); pk.y = cvtpk(o[2], o[3]); pk.z = cvtpk(o[4], o[5]); pk.w = cvtpk(o[6], o[7]);
        *(LAS v4u*)(dstl + swz_off<16>(4 * tg + tt, cc)) = pk; }
    asm volatile("" ::: "memory");
}
__device__ __forceinline__ void ml_passA(Frame& F) {
    const int lane = F.lane, w = F.wave, tid = F.tid, tb = w >> 1, vh = w & 1;
    unsigned char* ws = F.ws;
    const bf16* PROJ = (const bf16*)(ws + WS_PROJ); const float* GATES = (const float*)(ws + WS_GATES);
    LAS unsigned char* Kl = F.lds + ML_K; LAS unsigned char* Vl = F.lds + ML_V; LAS unsigned char* SM = F.lds + ML_SM;
    LAS float* wsc = (LAS float*)(SM + SM_WS);
    float* CLOC = (float*)((unsigned char*)F.out + MLG_CLOC); float* NLOC = (float*)(ws + MLG_NLOC); float* SCAL = (float*)(ws + MLG_SCAL);
#pragma unroll 1
    for (int u = F.vcu; u < 1024; u += F.G) {
        const int bh = u >> 5, c = u & 31, b = bh >> 2, h = bh & 3;
        const size_t rowbase = (size_t)b * SEQ, t0 = rowbase + (size_t)c * 128;
        int hx = lane >> 5, qx = lane & 31, tx = tid; asm volatile("" : "+v"(hx), "+v"(qx), "+v"(tx));
        const int tg = tx >> 4, cc = tx & 15;
        const int trbn = tr_base_nat(hx * 32 + qx, ML_VST);
        v4u rk[7], vv[4]; float i0 = 0.f, i1 = 0.f, f0 = 0.f, f1 = 0.f;
        ml_conv_load(PROJ, rowbase, c, h, 1, tg, cc, rk);
        f32x4 cwk[4][2], cbk[2]; ml_conv_wload(F, h, 1, cc, cwk, cbk);
#pragma unroll
        for (int i = 0; i < 4; ++i) { const int id = tx + 512 * i, row = id >> 4, c16 = id & 15; vv[i] = *(const GAS v4u*)(PROJ + (t0 + row) * PROJ_N + PC_VM + h * 128 + 8 * c16); }
        if (w == 0) { const float* gp = GATES + (t0 + 2 * lane) * 8; i0 = gp[h]; i1 = gp[8 + h]; f0 = gp[4 + h]; f1 = gp[12 + h]; }
        __syncthreads();
        ml_conv_apply(F, 1, tg, cc, rk, cwk, cbk, Kl);
#pragma unroll
        for (int i = 0; i < 4; ++i) { const int id = tx + 512 * i, row = id >> 4, c16 = id & 15; *(LAS v4u*)(Vl + row * ML_VST + c16 * 16) = vv[i]; }
        if (w == 0) {
            const float incl = wave_scan_incl<false>(f0 + f1, lane);
            float excl = __shfl_up(incl, 1); if (lane == 0) excl = 0.f;
            const float b0 = excl + f0, b1 = incl, a0 = i0 - b0, a1 = i1 - b1;
            float mloc = fmaxf(a0, a1);
#pragma unroll
            for (int o = 1; o < 64; o <<= 1) mloc = fmaxf(mloc, __shfl_xor(mloc, o));
            const float bL = __shfl(b1, 63);
            wsc[2 * lane] = __expf(a0 - mloc); wsc[2 * lane + 1] = __expf(a1 - mloc);
            if (lane == 0) { SCAL[2 * u] = bL; SCAL[2 * u + 1] = mloc; }
        }
        __syncthreads();
#pragma unroll
        for (int tt = 0; tt < 4; ++tt) { const int s = 4 * tg + tt; const float wv = wsc[s]; LAS v4u* kp = (LAS v4u*)(Kl + swz_off<16>(s, cc)); const v4u raw = *kp; v4u o;
            o.x = pk2(bf_lo(raw.x) * wv, bf_hi(raw.x) * wv); o.y = pk2(bf_lo(raw.y) * wv, bf_hi(raw.y) * wv); o.z = pk2(bf_lo(raw.z) * wv, bf_hi(raw.z) * wv); o.w = pk2(bf_lo(raw.w) * wv, bf_hi(raw.w) * wv);
            *kp = o; }
        __syncthreads();
        f32x16 cacc[2];
#pragma unroll
        for (int r = 0; r < 16; ++r) { cacc[0][r] = 0.f; cacc[1][r] = 0.f; }
        { const int i16 = qx & 15, g4 = 2 * hx + (qx >> 4);
#pragma unroll
          for (int ks = 0; ks < 8; ++ks) {
              const bf16x8 av = tr_frag_nat(Vl + trbn + (16 * ks) * ML_VST + (32 * tb) * 2, ML_VST);
#pragma unroll
              for (int kb2 = 0; kb2 < 2; ++kb2) { const int kcol = 32 * (2 * vh + kb2) + 16 * (g4 & 1) + 4 * (i16 & 3); const int srow = 16 * ks + 8 * hx + (i16 >> 2);
                  const v4i16_t lo = tr16(Kl + swz_off<16>(srow, kcol >> 3) + (kcol & 7) * 2), hi = tr16(Kl + swz_off<16>(srow + 4, kcol >> 3) + (kcol & 7) * 2);
                  const bf16x8 bk = (bf16x8){lo[0], lo[1], lo[2], lo[3], hi[0], hi[1], hi[2], hi[3]};
                  cacc[kb2] = MFMA32(av, bk, cacc[kb2]); } } }
        { bf16* cb = (bf16*)CLOC + (size_t)u * 16384;
#pragma unroll
          for (int kb2 = 0; kb2 < 2; ++kb2)
#pragma unroll
            for (int r = 0; r < 16; ++r) cb[(unsigned)(32 * tb + crow(r, hx)) * 128 + 32 * (2 * vh + kb2) + qx] = (bf16)f2bf(cacc[kb2][r]); }
        if (tx < 128) { const int k = tx; float a = 0.f;
            for (int s = 0; s < 128; ++s) a += bf_lo((unsigned)*(const LAS unsigned short*)(Kl + swz_off<16>(s, k >> 3) + (k & 7) * 2));
            NLOC[(size_t)u * 128 + k] = a; }
    }
    __syncthreads();
}
__device__ __forceinline__ void ml_passB(Frame& F) {
    const int tid = F.tid;
    unsigned char* ws = F.ws;
    const float* CLOC = (const float*)((unsigned char*)F.out + MLG_CLOC); unsigned char* CST = (unsigned char*)F.out + MLG_CST;
    const float* NLOC = (const float*)(ws + MLG_NLOC); float* NST = (float*)(ws + MLG_NST); const float* SCAL = (const float*)(ws + MLG_SCAL); float* MST = (float*)(ws + MLG_MST);
    LAS float* al = (LAS float*)F.lds; LAS float* be = al + 32;
#pragma unroll 1
    for (int it = F.vcu; it < 256; it += F.G) {
        const int bh = it >> 3, sl = it & 7;
        __syncthreads();
        if (tid < 64) {
            const int lc = tid & 31; const float fmx = SCAL[2 * (bh * 32 + lc)], fmy = SCAL[2 * (bh * 32 + lc) + 1];
            float m = 0.f, a_mine = 0.f, b_mine = 0.f, m_mine = 0.f;
#pragma unroll 1
            for (int c = 0; c < 32; ++c) { const float Fc = __builtin_bit_cast(float, __builtin_amdgcn_readlane(__builtin_bit_cast(int, fmx), c)), Ml = __builtin_bit_cast(float, __builtin_amdgcn_readlane(__builtin_bit_cast(int, fmy), c));
                const float Mx = fmaxf(m, Ml), a = __expf(m - Mx), b = __expf(Ml - Mx);
                if (tid == c) { a_mine = a; b_mine = b; m_mine = m; }
                m = Fc + Mx; }
            if (tid < 32) { al[tid] = a_mine; be[tid] = b_mine; if (sl == 0) MST[bh * 32 + tid] = m_mine; } }
        __syncthreads();
        const int g4 = sl * 512 + tid, v = g4 >> 5, kq = g4 & 31;
        const unsigned dsto = (unsigned)(swz_off<16>(v, kq >> 1) + (kq & 1) * 8);
        f32x4 st = (f32x4){0.f, 0.f, 0.f, 0.f};
#pragma unroll 1
        for (int c0 = 0; c0 < 32; c0 += 8) {
            u32x2g clr[8]; f32x4 cl[8];
#pragma unroll
            for (int j = 0; j < 8; ++j) clr[j] = __builtin_nontemporal_load((const GAS u32x2g*)((const bf16*)CLOC + (size_t)(bh * 32 + c0 + j) * 16384 + (size_t)g4 * 4));
#pragma unroll
            for (int j = 0; j < 8; ++j) { const unsigned lo_ = clr[j].x, hi_ = clr[j].y; cl[j] = (f32x4){bf_lo(lo_), bf_hi(lo_), bf_lo(hi_), bf_hi(hi_)}; }
#pragma unroll
            for (int j = 0; j < 8; ++j) { const int c = c0 + j;
                u32x2g o; o.x = pk2(st.x, st.y); o.y = pk2(st.z, st.w);
                *(GAS u32x2g*)(CST + (size_t)(bh * 32 + c) * 32768 + dsto) = o;
                const float a = al[c], bb = be[c]; st = st * a + cl[j] * bb; }
        }
        if (sl == 0 && tid < 128) { float n = 0.f;
            for (int c = 0; c < 32; ++c) { NST[(size_t)(bh * 32 + c) * 128 + tid] = n; n = al[c] * n + be[c] * NLOC[(size_t)(bh * 32 + c) * 128 + tid]; } }
    }
    __syncthreads();
}
__device__ __forceinline__ void ml_passC(Frame& F) {
    const int lane = F.lane, w = F.wave, tid = F.tid, tb = w >> 1, vh = w & 1;
    unsigned char* ws = F.ws;
    const bf16* PROJ = (const bf16*)(ws + WS_PROJ); bf16* MIXED = (bf16*)(ws + WS_MIX); const float* GATES = (const float*)(ws + WS_GATES);
    const unsigned char* CST = (const unsigned char*)F.out + MLG_CST; const float* NST = (const float*)(ws + MLG_NST); const float* MST = (const float*)(ws + MLG_MST);
    LAS unsigned char* Ql = F.lds + ML_Q; LAS unsigned char* Kl = F.lds + ML_K; LAS unsigned char* Cl = F.lds + ML_C; LAS unsigned char* Vl = F.lds + ML_V;
    LAS unsigned char* SM = F.lds + ML_SM;
    LAS float* a2 = (LAS float*)(SM + SM_A2); LAS float* M2 = (LAS float*)(SM + SM_M2); LAS float* emt = (LAS float*)(SM + SM_EMT); LAS float* inter = (LAS float*)(SM + SM_INTER);
    LAS unsigned short* nb = (LAS unsigned short*)(SM + SM_NB); LAS float* ssqp = (LAS float*)(SM + SM_SSQ);
    const bf16x8 ones = (bf16x8){0x3F80, 0x3F80, 0x3F80, 0x3F80, 0x3F80, 0x3F80, 0x3F80, 0x3F80};
#pragma unroll 1
    for (int u = F.vcu; u < 1024; u += F.G) {
        const int bh = u >> 5, c = u & 31, b = bh >> 2, h = bh & 3;
        const size_t rowbase = (size_t)b * SEQ, t0 = rowbase + (size_t)c * 128;
        int hx = lane >> 5, qx = lane & 31, tx = tid; asm volatile("" : "+v"(hx), "+v"(qx), "+v"(tx));
        const int tg = tx >> 4, cc = tx & 15;
        const int trb = tr_base(hx * 32 + qx, ML_VST);
        v4u rq[7], rk[7], vv[4], cv[4]; float nstv = 0.f, m_run = 0.f, i0 = 0.f, i1 = 0.f, f0 = 0.f, f1 = 0.f;
        ml_conv_load(PROJ, rowbase, c, h, 0, tg, cc, rq);
        ml_conv_load(PROJ, rowbase, c, h, 1, tg, cc, rk);
        f32x4 cwq[4][2], cbq[2], cwk[4][2], cbk[2]; ml_conv_wload(F, h, 0, cc, cwq, cbq); ml_conv_wload(F, h, 1, cc, cwk, cbk);
#pragma unroll
        for (int i = 0; i < 4; ++i) { const int id = tx + 512 * i, row = id >> 4, c16 = id & 15;
            vv[i] = *(const GAS v4u*)(PROJ + (t0 + row) * PROJ_N + PC_VM + h * 128 + 8 * c16);
            cv[i] = __builtin_nontemporal_load((const GAS v4u*)(CST + (size_t)u * 32768 + (size_t)id * 16)); }
        if (tx < 128) nstv = NST[(size_t)u * 128 + tx];
        if (w == 0) { m_run = MST[u]; const float* gp = GATES + (t0 + 2 * lane) * 8; i0 = gp[h]; i1 = gp[8 + h]; f0 = gp[4 + h]; f1 = gp[12 + h]; }
        __syncthreads();
        ml_conv_apply(F, 0, tg, cc, rq, cwq, cbq, Ql);
        ml_conv_apply(F, 1, tg, cc, rk, cwk, cbk, Kl);
#pragma unroll
        for (int i = 0; i < 4; ++i) { const int id = tx + 512 * i, row = id >> 4, c16 = id & 15;
            *(LAS v4u*)(Vl + row * ML_VST + c16 * 16) = vv[i];
            *(LAS v4u*)(Cl + id * 16) = cv[i]; }
        if (tx < 128) nb[tx] = (unsigned short)f2bf(nstv);
        if (w == 0) {
            const float incl = wave_scan_incl<false>(f0 + f1, lane);
            float excl = __shfl_up(incl, 1); if (lane == 0) excl = 0.f;
            const float b0 = excl + f0, b1 = incl;
            const float a0 = i0 - b0, a1 = i1 - b1;
            const float inclm = wave_scan_incl<true>(fmaxf(a0, a1), lane);
            float exclm = __shfl_up(inclm, 1); if (lane == 0) exclm = -INFINITY;
            const float M0 = fmaxf(m_run, fmaxf(exclm, a0)), M1 = fmaxf(m_run, inclm);
            a2[2 * lane] = a0 * LOG2E; a2[2 * lane + 1] = a1 * LOG2E; M2[2 * lane] = M0 * LOG2E; M2[2 * lane + 1] = M1 * LOG2E;
            inter[2 * lane] = __expf(m_run - M0); inter[2 * lane + 1] = __expf(m_run - M1);
            emt[2 * lane] = __expf(-(b0 + M0)); emt[2 * lane + 1] = __expf(-(b1 + M1));
        }
        __syncthreads();
        const float mng0 = F.in[I_MNG][h * 128 + 64 * vh + qx], mng1 = F.in[I_MNG][h * 128 + 64 * vh + 32 + qx];
        unsigned og[16];
        { const bf16* ogb = PROJ + t0 * PROJ_N; const unsigned ogo = (unsigned)(32 * tb) * PROJ_N + PC_OM + h * 128 + 64 * vh + qx;
#pragma unroll
          for (int r = 0; r < 16; ++r) { const unsigned oo = ogo + (unsigned)crow(r, hx) * PROJ_N; og[r] = (unsigned)ogb[oo] | ((unsigned)ogb[oo + 32] << 16); } }
        f32x16 hn0, hn1, dn;
#pragma unroll
        for (int r = 0; r < 16; ++r) { hn0[r] = 0.f; hn1[r] = 0.f; dn[r] = 0.f; }
        bf16x8 qa[8];
#pragma unroll
        for (int ks = 0; ks < 8; ++ks) qa[ks] = *(const LAS bf16x8*)(Ql + swz_off<16>(32 * tb + qx, 2 * ks + hx));
#pragma unroll
        for (int ks = 0; ks < 8; ++ks) {
            hn0 = MFMA32(qa[ks], *(const LAS bf16x8*)(Cl + swz_off<16>(32 * (2 * vh) + qx, 2 * ks + hx)), hn0);
            hn1 = MFMA32(qa[ks], *(const LAS bf16x8*)(Cl + swz_off<16>(32 * (2 * vh + 1) + qx, 2 * ks + hx)), hn1);
            dn = MFMA32(qa[ks], *(const LAS bf16x8*)((LAS unsigned char*)nb + (16 * ks + 8 * hx) * 2), dn);
        }
#pragma unroll
        for (int r = 0; r < 16; ++r) { const float it = inter[32 * tb + crow(r, hx)]; hn0[r] *= it; hn1[r] *= it; dn[r] *= it; }
        const float M2t = M2[32 * tb + qx];
#pragma unroll 1
        for (int sb = 0; sb <= tb; ++sb) {
            f32x16 st;
#pragma unroll
            for (int r = 0; r < 16; ++r) st[r] = 0.f;
#pragma unroll
            for (int ks = 0; ks < 8; ++ks) st = MFMA32(*(const LAS bf16x8*)(Kl + swz_off<16>(32 * sb + qx, 2 * ks + hx)), qa[ks], st);
            const bool diag = (sb == tb);
#pragma unroll
            for (int r = 0; r < 16; ++r) { float p = st[r] * __builtin_amdgcn_exp2f(a2[32 * sb + crow(r, hx)] - M2t);
                if (diag) p = (crow(r, hx) <= qx) ? p : 0.f;
                st[r] = p; }
            const bf16x8 pa0 = pack8<0>(st), pa1 = pack8<1>(st);
            const LAS unsigned char* vb = Vl + trb + (32 * sb) * ML_VST + (64 * vh) * 2;
            hn0 = MFMA32(pa0, tr_frag(vb, ML_VST), hn0);
            hn1 = MFMA32(pa0, tr_frag(vb + 64, ML_VST), hn1);
            dn = MFMA32(pa0, ones, dn);
            hn0 = MFMA32(pa1, tr_frag(vb + 16 * ML_VST, ML_VST), hn0);
            hn1 = MFMA32(pa1, tr_frag(vb + 16 * ML_VST + 64, ML_VST), hn1);
            dn = MFMA32(pa1, ones, dn);
        }
        asm volatile("" ::: "memory");
        {
#pragma unroll
          for (int r = 0; r < 16; ++r) { const int rl = crow(r, hx); const int trow = 32 * tb + rl;
            const float dv = __builtin_amdgcn_rcpf(fmaxf(fabsf(dn[r]), emt[trow]));
            const float g0 = bf_lo(og[r]), g1 = bf_hi(og[r]);
            hn0[r] = hn0[r] * dv * __builtin_amdgcn_rcpf(1.0f + __expf(-g0)); hn1[r] = hn1[r] * dv * __builtin_amdgcn_rcpf(1.0f + __expf(-g1));
            float v = hn0[r] * hn0[r] + hn1[r] * hn1[r]; v = row_sum_f(v); v = xadd16(v);
            if (qx == 0) ssqp[w * 32 + rl] = v; } }
        __syncthreads();
        { const float gg0 = mng0, gg1 = mng1;
          bf16* opb = MIXED + t0 * D; const unsigned opo = (unsigned)(32 * tb) * D + h * 128 + 64 * vh + qx;
#pragma unroll
          for (int r = 0; r < 16; ++r) { const int rr = crow(r, hx); const float tot = ssqp[w * 32 + rr] + ssqp[(w ^ 1) * 32 + rr];
              const float rs = rsqrtf(tot * (1.0f / 128.0f) + EPS);
              const unsigned oo = opo + (unsigned)rr * D;
              opb[oo] = (bf16)f2bf(hn0[r] * rs * gg0); opb[oo + 32] = (bf16)f2bf(hn1[r] * rs * gg1); } }
    }
    __syncthreads();
}
constexpr int CW_SBQ = 8192; constexpr float SB_CUT = 40.0f;
constexpr int SB_KB = 8192, SB_VST = 192, SB_VB = 64 * SB_VST, SB_BUF = SB_KB + SB_VB;
__device__ __forceinline__ void sb_unit(Frame& F, int b, int h, int qt) {
    int tid_o = F.tid; asm volatile("" : "+v"(tid_o));
    const int lane = tid_o & 63, w = F.wave, tid = tid_o;
    int q32 = lane & 31, hh = lane >> 5; asm volatile("" : "+v"(q32), "+v"(hh));
    unsigned char* ws = F.ws;
    const bf16* PROJ = (const bf16*)(ws + WS_PROJ); bf16* MIXED = (bf16*)(ws + WS_MIX);
    const size_t rowbase = (size_t)b * SEQ;
    const int Q0 = qt * 256, qmin = Q0 + 32 * w, qmax = qmin + 31, query = qmin + q32;
    const float g0 = F.in[I_SNG][h * 64 + q32], g1 = F.in[I_SNG][h * 64 + 32 + q32];
    bf16x8 qf[4];
    { const bf16* qp = PROJ + (rowbase + query) * PROJ_N + PC_QS + h * 64 + 8 * hh;
#pragma unroll
      for (int ks = 0; ks < 4; ++ks) qf[ks] = *(const bf16x8*)(qp + 16 * ks); }
    f32x16 o0, o1;
#pragma unroll
    for (int r = 0; r < 16; ++r) { o0[r] = 0.f; o1[r] = 0.f; }
    float carry = 0.f;
    const int srow = tid >> 3, sc = tid & 7;
    const bf16* ksrc = PROJ + (rowbase + srow) * PROJ_N + PC_KS + h * 64 + sc * 8;
    const bf16* vsrc = PROJ + (rowbase + srow) * PROJ_N + PC_VS + h * 64 + sc * 8;
    const int kdst = swz_off<8>(srow, sc), vdst = SB_KB + srow * SB_VST + sc * 16;
    const int trb = tr_base(lane, SB_VST);
    const int jt_max = Q0 / 64 + 3;
    const int jt_lo = (jt_max > 4) ? jt_max - 4 : 0;
    __syncthreads();
    { v4u kv[5], vv[5];
#pragma unroll
      for (int i = 0; i < 5; ++i) { const int jc = (jt_max - i > 0) ? jt_max - i : 0; kv[i] = *(const GAS v4u*)(ksrc + (size_t)jc * 64 * PROJ_N); vv[i] = *(const GAS v4u*)(vsrc + (size_t)jc * 64 * PROJ_N); }
#pragma unroll
      for (int i = 0; i < 5; ++i) { *(LAS v4u*)(F.lds + i * SB_BUF + kdst) = kv[i]; *(LAS v4u*)(F.lds + i * SB_BUF + vdst) = vv[i]; } }
    __syncthreads();
    volatile LAS unsigned* dflag = F.MISC + 32;
#define SB_SUB(jt, s, Kl, Vl) do { const int kbase = 64 * (jt) + 32 * (s); if (kbase < qmax) { \
                f32x16 acc; \
                _Pragma("unroll") \
                for (int r = 0; r < 16; ++r) acc[r] = 0.f; \
                _Pragma("unroll") \
                for (int ks = 0; ks < 4; ++ks) acc = MFMA32(*(const LAS bf16x8*)(Kl + swz_off<8>(32 * s + q32, 2 * ks + hh)), qf[ks], acc); \
                const bool need_mask = (kbase + 31 >= qmin); \
                float l[16]; \
                _Pragma("unroll") \
                for (int r = 0; r < 16; ++r) { const float z = acc[r]; const float t = __builtin_amdgcn_exp2f(-fabsf(z)); const float u = __builtin_amdgcn_logf(1.0f + t); \
                    float lr = -(fmaxf(z, 0.f) + u); \
                    if (need_mask) lr = (kbase + crow(r, hh) < query) ? lr : 0.f; \
                    l[r] = lr; } \
                _Pragma("unroll") \
                for (int g = 0; g < 4; ++g) { l[4 * g + 2] += l[4 * g + 3]; l[4 * g + 1] += l[4 * g + 2]; l[4 * g] += l[4 * g + 1]; } \
                float Go[4], Tg[4]; \
                _Pragma("unroll") \
                for (int g = 0; g < 4; ++g) { Go[g] = __shfl_xor(l[4 * g], 32); Tg[g] = l[4 * g] + Go[g]; } \
                const float U2 = Tg[3], U1 = U2 + Tg[2], U0 = U1 + Tg[1], total = U0 + Tg[0]; \
                float off[4]; \
                off[3] = carry; off[2] = carry + U2; off[1] = carry + U1; off[0] = carry + U0; \
                if (hh == 0) { \
                _Pragma("unroll") \
                    for (int g = 0; g < 4; ++g) off[g] += Go[g]; } \
                _Pragma("unroll") \
                for (int r = 0; r < 16; ++r) { float a = __builtin_amdgcn_exp2f(acc[r] + l[r] + off[r >> 2]); \
                    if (need_mask) a = (kbase + crow(r, hh) < query) ? a : 0.f; \
                    acc[r] = a; } \
                carry += total; \
                const bf16x8 pa0 = pack8<0>(acc), pa1 = pack8<1>(acc); \
                const LAS unsigned char* vb = Vl + trb + (32 * s) * SB_VST; \
                o0 = MFMA32(pa0, tr_frag(vb, SB_VST), o0); \
                o1 = MFMA32(pa0, tr_frag(vb + 64, SB_VST), o1); \
                o0 = MFMA32(pa1, tr_frag(vb + 16 * SB_VST, SB_VST), o0); \
                o1 = MFMA32(pa1, tr_frag(vb + 16 * SB_VST + 64, SB_VST), o1); \
            } } while (0)
#pragma unroll 1
    for (int jt = Q0 / 64 + (w >> 1); jt >= jt_lo; --jt) {
        if (__all(carry < -SB_CUT) != 0) break;
        const LAS unsigned char* Kl = F.lds + (jt_max - jt) * SB_BUF; const LAS unsigned char* Vl = Kl + SB_KB;
        SB_SUB(jt, 1, Kl, Vl);
        SB_SUB(jt, 0, Kl, Vl);
    }
    { const unsigned dw = (__all(carry < -SB_CUT) != 0) ? 1u : 0u;
      if (lane == 0) dflag[16 + w] = dw; }
    __syncthreads();
    unsigned alld0 = 1u;
#pragma unroll
    for (int i = 0; i < 8; ++i) alld0 &= dflag[16 + i];
    if (!alld0 && jt_lo > 0) {
        const int jt_top = jt_lo - 1;
        { const v4u kv = *(const GAS v4u*)(ksrc + (size_t)jt_top * 64 * PROJ_N), vv = *(const GAS v4u*)(vsrc + (size_t)jt_top * 64 * PROJ_N);
          *(LAS v4u*)(F.lds + kdst) = kv; *(LAS v4u*)(F.lds + vdst) = vv; }
        __syncthreads();
        int cur = 0;
#pragma unroll 1
        for (int jt = jt_top; jt >= 0; --jt) {
            const bool done_w = __all(carry < -SB_CUT) != 0;
            v4u kn, vn;
            if (jt > 0) { kn = *(const GAS v4u*)(ksrc + (size_t)(jt - 1) * 64 * PROJ_N); vn = *(const GAS v4u*)(vsrc + (size_t)(jt - 1) * 64 * PROJ_N); }
            const LAS unsigned char* Kl = F.lds + cur * SB_BUF; const LAS unsigned char* Vl = Kl + SB_KB;
            if (!done_w) { SB_SUB(jt, 1, Kl, Vl); SB_SUB(jt, 0, Kl, Vl); }
            if (jt > 0) { LAS unsigned char* nb = F.lds + (cur ^ 1) * SB_BUF; *(LAS v4u*)(nb + kdst) = kn; *(LAS v4u*)(nb + vdst) = vn; }
            { const unsigned dw = (__all(carry < -SB_CUT) != 0) ? 1u : 0u;
              if (lane == 0) dflag[(jt & 1) * 8 + w] = dw; }
            __syncthreads();
            cur ^= 1;
            { unsigned alld = 1u;
#pragma unroll
              for (int i = 0; i < 8; ++i) alld &= dflag[(jt & 1) * 8 + i];
              if (alld) break; }
        }
    }
#undef SB_SUB
#pragma unroll
    for (int r = 0; r < 16; ++r) { float v = o0[r] * o0[r] + o1[r] * o1[r]; v = row_sum_f(v); v = xadd16(v);
        const float rs = rsqrtf(v * (1.0f / 64.0f) + EPS);
        bf16* opb = MIXED + (rowbase + qmin) * D; const unsigned oo = (unsigned)crow(r, hh) * D + 512 + h * 64 + q32;
        opb[oo] = (bf16)f2bf(o0[r] * rs * g0); opb[oo + 32] = (bf16)f2bf(o1[r] * rs * g1); }
}
__device__ __forceinline__ void sb_phase(Frame& F, int qoff) {
    unsigned nxt = 0u;
    if (F.tid == 0) nxt = __hip_atomic_fetch_add((unsigned*)(F.ctl + CW_SBQ + qoff), 1u, __ATOMIC_RELAXED, __HIP_MEMORY_SCOPE_AGENT);
    for (;;) {
        __syncthreads();
        if (F.tid == 0) F.MISC[16] = nxt;
        __syncthreads();
        const int u = (int)F.MISC[16];
        if (u >= 1280) break;
        if (F.tid == 0) nxt = __hip_atomic_fetch_add((unsigned*)(F.ctl + CW_SBQ + qoff), 1u, __ATOMIC_RELAXED, __HIP_MEMORY_SCOPE_AGENT);
        if (u < 1024) { const int qt = 15 - (u >> 6), bh = u & 63;
            sb_unit(F, bh >> 3, bh & 7, qt); }
        else p0_fold_item(F, u - 1024);
    }
}
__device__ __forceinline__ void p5_phase(Frame& F) {
    const int w = F.wave, qb = w >> 1, dh = w & 1;
    unsigned char* ws = F.ws;
    const bf16* QX = (const bf16*)(ws + WS_MIX); const bf16* KVX = (const bf16*)(ws + WS_KVX); bf16* OX = (bf16*)(ws + WS_OX);
    constexpr int XBUF = 32768 + 64 * 576;
    LAS float* wsf = (LAS float*)(F.lds + 2 * XBUF) + w * 64;
    constexpr int VST = 576;
    for (int u = F.vcu; u < 1024; u += F.G) {
        int lane = F.lane, tidx = F.tid; asm volatile("" : "+v"(lane), "+v"(tidx));
        const int q32 = lane & 31, hh = lane >> 5, trb = tr_base(lane, VST);
        const int tile = u >> 2, h = u & 3, t0 = tile * 128, b = t0 >> 12;
        bf16x8 qf[16];
        { const bf16* qp = QX + (size_t)(t0 + 32 * qb + q32) * D + h * 256 + 8 * hh;
#pragma unroll
          for (int ks = 0; ks < 16; ++ks) qf[ks] = *(const bf16x8*)(qp + 16 * ks); }
        f32x16 o[4];
#pragma unroll
        for (int i = 0; i < 4; ++i)
#pragma unroll
            for (int r = 0; r < 16; ++r) o[i][r] = 0.f;
        float m_run = -1e30f, l_run = 0.f;
        const int srow = tidx >> 5, sc = tidx & 31;
        const bf16* kvsrc = KVX + (size_t)(b * 256 + srow) * 2048 + h * 256 + sc * 8;
        v4u kn[4], vn[4];
#pragma unroll
        for (int i = 0; i < 4; ++i) { kn[i] = *(const GAS v4u*)(kvsrc + (size_t)(16 * i) * 2048); vn[i] = *(const GAS v4u*)(kvsrc + (size_t)(16 * i) * 2048 + 1024); }
#pragma unroll
        for (int i = 0; i < 4; ++i) { const int row = srow + 16 * i; *(LAS v4u*)(F.lds + swz_off<32>(row, sc)) = kn[i]; *(LAS v4u*)(F.lds + 32768 + row * VST + sc * 16) = vn[i]; }
        __syncthreads();
        int cur = 0;
#pragma unroll 1
        for (int kt = 0; kt < 4; ++kt) {
            if (kt < 3) {
#pragma unroll
                for (int i = 0; i < 4; ++i) { kn[i] = *(const GAS v4u*)(kvsrc + (size_t)(64 * (kt + 1) + 16 * i) * 2048); vn[i] = *(const GAS v4u*)(kvsrc + (size_t)(64 * (kt + 1) + 16 * i) * 2048 + 1024); } }
            const LAS unsigned char* Kl = F.lds + cur * XBUF; const LAS unsigned char* Vl = Kl + 32768;
            f32x16 s0, s1;
#pragma unroll
            for (int r = 0; r < 16; ++r) { s0[r] = 0.f; s1[r] = 0.f; }
#pragma unroll
            for (int ks = 0; ks < 16; ++ks) {
                const bf16x8 k0 = *(const LAS bf16x8*)(Kl + swz_off<32>(q32, 2 * ks + hh));
                const bf16x8 k1 = *(const LAS bf16x8*)(Kl + swz_off<32>(32 + q32, 2 * ks + hh));
                s0 = MFMA32(k0, qf[ks], s0); s1 = MFMA32(k1, qf[ks], s1);
            }
            float mx = fmaxf(s0[0], s1[0]);
#pragma unroll
            for (int r = 1; r < 16; ++r) mx = fmaxf(mx, fmaxf(s0[r], s1[r]));
            mx = xmax32(mx);
            const float m_new = fmaxf(m_run, mx), alpha = __builtin_amdgcn_exp2f(m_run - m_new);
            float rs = 0.f;
#pragma unroll
            for (int r = 0; r < 16; ++r) { s0[r] = __builtin_amdgcn_exp2f(s0[r] - m_new); s1[r] = __builtin_amdgcn_exp2f(s1[r] - m_new); rs += s0[r] + s1[r]; }
            rs = xadd32(rs);
            l_run = l_run * alpha + rs; m_run = m_new;
            if (hh == 0) wsf[q32] = alpha;
            asm volatile("s_waitcnt lgkmcnt(0)" ::: "memory");
#pragma unroll
            for (int r = 0; r < 16; ++r) { const float a = wsf[crow(r, hh)];
#pragma unroll
                for (int i = 0; i < 4; ++i) o[i][r] *= a; }
            const bf16x8 p00 = pack8<0>(s0), p01 = pack8<1>(s0), p10 = pack8<0>(s1), p11 = pack8<1>(s1);
#pragma unroll
            for (int i = 0; i < 4; ++i) { const LAS unsigned char* vb = Vl + trb + (dh * 128 + i * 32) * 2;
                o[i] = MFMA32(p00, tr_frag(vb, VST), o[i]);
                o[i] = MFMA32(p01, tr_frag(vb + 16 * VST, VST), o[i]);
                o[i] = MFMA32(p10, tr_frag(vb + 32 * VST, VST), o[i]);
                o[i] = MFMA32(p11, tr_frag(vb + 48 * VST, VST), o[i]); }
            if (kt < 3) { LAS unsigned char* nb = F.lds + (cur ^ 1) * XBUF;
#pragma unroll
                for (int i = 0; i < 4; ++i) { const int row = srow + 16 * i; *(LAS v4u*)(nb + swz_off<32>(row, sc)) = kn[i]; *(LAS v4u*)(nb + 32768 + row * VST + sc * 16) = vn[i]; } }
            __syncthreads();
            cur ^= 1;
        }
        if (hh == 0) wsf[32 + q32] = l_run;
        asm volatile("s_waitcnt lgkmcnt(0)" ::: "memory");
#pragma unroll
        for (int r = 0; r < 16; ++r) { const float inv = 1.0f / wsf[32 + crow(r, hh)];
            bf16* op = OX + (size_t)(t0 + 32 * qb + crow(r, hh)) * D + h * 256 + dh * 128 + q32;
#pragma unroll
            for (int i = 0; i < 4; ++i) op[i * 32] = (bf16)f2bf(o[i][r] * inv); }
    }
    __syncthreads();
}
#define P5_BODY p5_phase(F);
typedef __bf16 bf16v2 __attribute__((ext_vector_type(2)));

__device__ __forceinline__ unsigned f16_sortable(unsigned s) { return (s & 0x8000u) ? (s ^ 0xFFFFu) : (s | 0x8000u); }
__device__ __forceinline__ float sortable_f16_to_f32(unsigned m) { const unsigned s = (m & 0x8000u) ? (m ^ 0x8000u) : (m ^ 0xFFFFu); return (float)__builtin_bit_cast(_Float16, (unsigned short)s); }
__device__ __forceinline__ unsigned f32_sortable(float f) { const unsigned b = __builtin_bit_cast(unsigned, f); return (b & 0x80000000u) ? ~b : (b | 0x80000000u); }
__device__ __forceinline__ float gelu_erf(float v) {
    const float av = fabsf(v), t = __builtin_amdgcn_rcpf(av * 0.2316418882f + 1.0f);
    float q = t * 0.5307027145f + (-0.7265760135f); q = q * t + 0.7107068705f; q = q * t + (-0.142248368f); q = q * t + 0.127414796f; q = q * t;
    const float e = __builtin_amdgcn_exp2f((v * v) * (-0.72134752044f));
    const float m = v * (q * e);
    return v < 0.f ? m : v - m;
}

constexpr int CW_P8S = 16384;
#ifndef P8_SYNC_EVERY
#define P8_SYNC_EVERY 0
#endif
__device__ __forceinline__ void p8_group_sync(Frame& F, unsigned target, int slot) {
    __syncthreads();
    if (F.tid == 0) {
        unsigned* c = (unsigned*)(F.ctl + CW_P8S + slot * 256) + (F.vcu / (F.G / 8)) * 32;
        __hip_atomic_fetch_add(c, 1u, __ATOMIC_RELAXED, __HIP_MEMORY_SCOPE_AGENT);
        while (__hip_atomic_load(c, __ATOMIC_RELAXED, __HIP_MEMORY_SCOPE_AGENT) < target) __builtin_amdgcn_s_sleep(1);
    }
    __syncthreads();
}
template <unsigned EMASK, int SLOT = 0, int NOCOMP = 0> __device__ __forceinline__ void p8_phase(Frame& F, float* XOUT) {
    const int gw = F.vcu * NWAVES + F.wave, NGW = F.G * NWAVES;
    LAS unsigned char* wl = F.lds + F.wave * 12288;
    LAS unsigned* sk = (LAS unsigned*)(wl + 2048);
    LAS unsigned* peA = (LAS unsigned*)wl; LAS float* pgA = (LAS float*)(wl + 512); LAS unsigned* peB = (LAS unsigned*)(wl + 1024); LAS float* pgB = (LAS float*)(wl + 1536);
    LAS float* xnA = (LAS float*)(wl + 4096); LAS float* xnB = (LAS float*)(wl + 8192);
    LAS float* psA = (LAS float*)(wl + 3072); LAS float* psB = (LAS float*)(wl + 3584);
    unsigned char* ws = F.ws;
    const unsigned short* SC = (const unsigned short*)(ws + WS_SC); const float* ssq2 = (const float*)(ws + WS_SSQ2);
    const float* fg = F.in[I_FFNG]; const float* fing = F.in[I_FING]; const bf16* X = (const bf16*)(ws + WS_XB);
    const unsigned char* UB = ws + WS_UB;
    const float* USC = (const float*)(ws + WS_USC);
    v4u raw4n[4];
    if (gw < T) { const int lane0 = F.lane;
#pragma unroll
        for (int bi = 0; bi < 4; ++bi) raw4n[bi] = *(const GAS v4u*)(SC + (size_t)gw * 2048 + bi * 512 + lane0 * 8); }
    unsigned sweep_rev = 0u;
    for (int tA = gw; tA < T; tA += 2 * NGW) {
        const int tB = (tA + NGW < T) ? tA + NGW : tA;
        v4u pa[4], pb[4]; u32x2f qa[4], qb[4];
#pragma unroll 1
        for (int w = 0; w < 2; ++w) {
            const int t = w ? tB : tA;
            int lane = F.lane; asm volatile("" : "+v"(lane));
            const int j16 = lane & 15;
            LAS unsigned* pe = w ? peB : peA; LAS float* pg = w ? pgB : pgA; LAS float* ps = w ? psB : psA;
            u32x2f xb[4]; { const GAS u32x2f* xr = (const GAS u32x2f*)(X + (size_t)t * D) + lane;
#pragma unroll
              for (int j = 0; j < 4; ++j) xb[j] = xr[64 * j]; }
            float ssq_t; { const f32x4* sp = (const f32x4*)(ssq2 + (size_t)t * 16); const f32x4 a = sp[0], b = sp[1], c = sp[2], d = sp[3]; ssq_t = ((a[0] + a[1]) + (a[2] + a[3])) + ((b[0] + b[1]) + (b[2] + b[3])) + ((c[0] + c[1]) + (c[2] + c[3])) + ((d[0] + d[1]) + (d[2] + d[3])); }
            v4u raw4[4];
#pragma unroll
            for (int bi = 0; bi < 4; ++bi) raw4[bi] = raw4n[bi];
            if (w == 0) {
#pragma unroll
                for (int bi = 0; bi < 4; ++bi) raw4n[bi] = *(const GAS v4u*)(SC + (size_t)tB * 2048 + bi * 512 + lane * 8); }
        __builtin_amdgcn_s_setprio(2);
#define CE_(k, i_, j_) do { const unsigned hi_ = max(k[i_], k[j_]), lo_ = min(k[i_], k[j_]); k[i_] = hi_; k[j_] = lo_; } while (0)
#define SORT8_(k) do { CE_(k, 0, 1); CE_(k, 2, 3); CE_(k, 4, 5); CE_(k, 6, 7); CE_(k, 0, 2); CE_(k, 1, 3); CE_(k, 4, 6); CE_(k, 5, 7); CE_(k, 1, 2); CE_(k, 5, 6); CE_(k, 0, 4); CE_(k, 3, 7); \
                CE_(k, 1, 5); CE_(k, 2, 6); CE_(k, 1, 4); CE_(k, 3, 6); CE_(k, 2, 4); CE_(k, 3, 5); CE_(k, 3, 4); } while (0)
            {
                unsigned k0[8], k1[8], k2[8], k3[8];
#pragma unroll
                for (int e = 0; e < 8; ++e) { const unsigned lo = (unsigned)(255 - (j16 * 8 + e));
#define KEY_(b_) ((f16_sortable((e & 1) ? (raw4[b_][e >> 1] >> 16) : (raw4[b_][e >> 1] & 0xFFFFu)) << 16) | lo)
                    k0[e] = KEY_(0); k1[e] = KEY_(1); k2[e] = KEY_(2); k3[e] = KEY_(3); }
#undef KEY_
                SORT8_(k0); SORT8_(k1); SORT8_(k2); SORT8_(k3);
                unsigned mine0 = 0u, mine1 = 0u, mine2 = 0u, mine3 = 0u;
#pragma unroll 1
                for (int r = 0; r < 16; ++r) {
                    const unsigned m0 = row_max_u(k0[0]), m1 = row_max_u(k1[0]), m2 = row_max_u(k2[0]), m3 = row_max_u(k3[0]);
                    const bool me = (j16 == r);
                    mine0 = me ? m0 : mine0; mine1 = me ? m1 : mine1; mine2 = me ? m2 : mine2; mine3 = me ? m3 : mine3;
                    const bool wn0 = (k0[0] == m0), wn1 = (k1[0] == m1), wn2 = (k2[0] == m2), wn3 = (k3[0] == m3);
#pragma unroll
                    for (int e = 0; e < 7; ++e) { k0[e] = wn0 ? k0[e + 1] : k0[e]; k1[e] = wn1 ? k1[e + 1] : k1[e]; k2[e] = wn2 ? k2[e + 1] : k2[e]; k3[e] = wn3 ? k3[e + 1] : k3[e]; }
                    k0[7] = wn0 ? 0u : k0[7]; k1[7] = wn1 ? 0u : k1[7]; k2[7] = wn2 ? 0u : k2[7]; k3[7] = wn3 ? 0u : k3[7];
                }
                const int rr = lane >> 4, hf = (rr & 1) * 128, hb = (rr >> 1) * 16 + j16;
                sk[hf + hb] = mine0; sk[hf + 32 + hb] = mine1; sk[hf + 64 + hb] = mine2; sk[hf + 96 + hb] = mine3;
            }
#undef SORT8_
#undef CE_
            asm volatile("s_waitcnt lgkmcnt(0)" ::: "memory");
            {
                const unsigned tbl = (j16 == 0) ? 0x30201000u : (j16 == 1) ? 0x70605040u : (j16 == 2) ? 0xB0A09080u : (j16 == 3) ? 0xF0E0D0C0u : (j16 == 4) ? 0x31211101u : (j16 == 5) ? 0x71615141u
                                   : (j16 == 6) ? 0xFF221202u : (j16 == 7) ? 0xFFFF4232u : (j16 == 8) ? 0x33231303u : (j16 == 9) ? 0xFF241404u : (j16 == 10) ? 0xFFFF1505u : (j16 == 11) ? 0xFFFF1606u
                                   : (j16 == 12) ? 0xFFFF1707u : (j16 == 13) ? 0x0B0A0908u : (j16 == 14) ? 0x0F0E0D0Cu : 0xFFFFFFFFu;
                const int h0 = lane >> 4, h1 = 4 + (lane >> 4);
                const LAS unsigned* ska0 = sk + h0 * 16; const LAS unsigned* skb0 = sk + 128 + h0 * 16; const LAS unsigned* ska1 = sk + h1 * 16; const LAS unsigned* skb1 = sk + 128 + h1 * 16;
                unsigned c0[4], c1[4];
#pragma unroll
                for (int q = 0; q < 4; ++q) { const unsigned ent = (tbl >> (8 * q)) & 0xFFu; const bool ok = (ent != 0xFFu); const int ci = ok ? (int)(ent >> 4) : 0, cj = ok ? (int)(ent & 15u) : 0;
                    const float cv0 = sortable_f16_to_f32(ska0[ci] >> 16) + sortable_f16_to_f32(skb0[cj] >> 16), cv1 = sortable_f16_to_f32(ska1[ci] >> 16) + sortable_f16_to_f32(skb1[cj] >> 16);
                    const unsigned lo = (unsigned)(255 - (ci * 16 + cj));
                    c0[q] = ok ? ((f32_sortable(cv0) & ~0xFFu) | lo) : 0u; c1[q] = ok ? ((f32_sortable(cv1) & ~0xFFu) | lo) : 0u; }
                unsigned win0 = 0u, win1 = 0u;
#pragma unroll 1
                for (int r = 0; r < 16; ++r) {
                    const unsigned m0 = row_max_u(c0[0]), m1 = row_max_u(c1[0]);
                    win0 = (j16 == r) ? m0 : win0; win1 = (j16 == r) ? m1 : win1;
                    const bool wn0 = (c0[0] == m0), wn1 = (c1[0] == m1);
#pragma unroll
                    for (int i = 0; i < 3; ++i) { c0[i] = wn0 ? c0[i + 1] : c0[i]; c1[i] = wn1 ? c1[i + 1] : c1[i]; }
                    c0[3] = wn0 ? 0u : c0[3]; c1[3] = wn1 ? 0u : c1[3];
                }
#define FIN_(win, ska, skb, head) do { const int pos = 255 - (int)(win & 0xFFu); const unsigned kA = ska[pos >> 4], kB = skb[pos & 15]; \
                    const float best = sortable_f16_to_f32(kA >> 16) + sortable_f16_to_f32(kB >> 16); \
                    const unsigned expert = (255u - (kA & 0xFFFFu)) * 128u + (255u - (kB & 0xFFFFu)); \
                    const float mx = sortable_f16_to_f32(ska[0] >> 16) + sortable_f16_to_f32(skb[0] >> 16);        \
                    const float ex = __builtin_amdgcn_exp2f((best - mx) * LOG2E); const float sum = row_sum_f(ex); \
                    pe[(head) * 16 + j16] = expert; pg[(head) * 16 + j16] = ex / sum; } while (0)
                FIN_(win0, ska0, skb0, h0); FIN_(win1, ska1, skb1, h1);
#undef FIN_
            }
            {
                asm volatile("s_waitcnt lgkmcnt(0)" ::: "memory");
                const unsigned e0 = pe[lane], e1 = pe[lane + 64]; const float g0 = pg[lane], g1 = pg[lane + 64];
                const f32x2_t sc0 = *(const GAS f32x2_t*)(USC + 2 * e0), sc1 = *(const GAS f32x2_t*)(USC + 2 * e1);
                const unsigned b0 = (e0 >> 8) ^ sweep_rev, b1 = (e1 >> 8) ^ sweep_rev;
                sk[lane] = 0u;
                asm volatile("s_waitcnt lgkmcnt(0)" ::: "memory");
                const unsigned r0 = __hip_atomic_fetch_add(sk + b0, 1u, __ATOMIC_RELAXED, __HIP_MEMORY_SCOPE_WAVEFRONT), r1 = __hip_atomic_fetch_add(sk + b1, 1u, __ATOMIC_RELAXED, __HIP_MEMORY_SCOPE_WAVEFRONT);
                asm volatile("s_waitcnt lgkmcnt(0)" ::: "memory");
                const unsigned cnt = sk[lane];
                unsigned inc = cnt;
                inc += (unsigned)__builtin_amdgcn_update_dpp(0, (int)inc, 0x111, 0xf, 0xf, true); inc += (unsigned)__builtin_amdgcn_update_dpp(0, (int)inc, 0x112, 0xf, 0xf, true);
                inc += (unsigned)__builtin_amdgcn_update_dpp(0, (int)inc, 0x114, 0xf, 0xf, true); inc += (unsigned)__builtin_amdgcn_update_dpp(0, (int)inc, 0x118, 0xf, 0xf, true);
                const unsigned rt0 = (unsigned)__builtin_amdgcn_readlane((int)inc, 15), rt1 = (unsigned)__builtin_amdgcn_readlane((int)inc, 31), rt2 = (unsigned)__builtin_amdgcn_readlane((int)inc, 47);
                inc += ((lane >= 16) ? rt0 : 0u) + ((lane >= 32) ? rt1 : 0u) + ((lane >= 48) ? rt2 : 0u);
                sk[64 + lane] = inc - cnt;
                asm volatile("s_waitcnt lgkmcnt(0)" ::: "memory");
                const unsigned pos0 = sk[64 + b0] + r0, pos1 = sk[64 + b1] + r1;
                asm volatile("s_waitcnt lgkmcnt(0)" ::: "memory");
                pe[pos0] = e0; pg[pos0] = g0 * sc0.y; ps[pos0] = sc0.x; pe[pos1] = e1; pg[pos1] = g1 * sc1.y; ps[pos1] = sc1.x;
            }
            asm volatile("s_waitcnt lgkmcnt(0)" ::: "memory");
            __builtin_amdgcn_s_setprio(0);
            { const float r2 = rsqrtf(ssq_t * (1.0f / D) + EPS); const float* gr = fg + lane * 4; LAS f32x4* xo = (LAS f32x4*)(w ? xnB : xnA) + lane;
#pragma unroll
              for (int j = 0; j < 4; ++j) { const f32x4 xj = (f32x4){bf_lo(xb[j].x), bf_hi(xb[j].x), bf_lo(xb[j].y), bf_hi(xb[j].y)}; xo[64 * j] = xj * r2 * *(const f32x4*)(gr + 256 * j); } }
            if (w == 0) {
                asm volatile("s_waitcnt lgkmcnt(0)" ::: "memory");
#pragma unroll
                for (int q_ = 0; q_ < 4; ++q_) { const unsigned e_ = (unsigned)__builtin_amdgcn_readfirstlane((int)peA[q_]) & EMASK; const unsigned char* r_ = UB + (size_t)e_ * 1536; pa[q_] = *(const GAS v4u*)(r_ + lane * 16); qa[q_] = *(const GAS u32x2f*)(r_ + 1024 + lane * 8); } }
        }
        asm volatile("s_waitcnt lgkmcnt(0)" ::: "memory");
        int lane = F.lane; asm volatile("" : "+v"(lane));
        f32x2_t y2A[8], y2B[8];
#pragma unroll
        for (int i = 0; i < 8; ++i) { y2A[i] = (f32x2_t){0.f, 0.f}; y2B[i] = (f32x2_t){0.f, 0.f}; }
        f32x2_t sa, sb;
#define P8_LOAD(P_, Q_, SC_, PE_, s) do { _Pragma("unroll") for (int q_ = 0; q_ < 4; ++q_) { const unsigned e_ = (unsigned)__builtin_amdgcn_readfirstlane((int)PE_[(s) + q_]) & EMASK; \
            const unsigned char* r_ = UB + (size_t)e_ * 1536; P_[q_] = *(const GAS v4u*)(r_ + lane * 16); Q_[q_] = *(const GAS u32x2f*)(r_ + 1024 + lane * 8); } \
            { const unsigned el_ = PE_[(s) + (lane & 3)] & EMASK; SC_ = *(const GAS f32x2_t*)(USC + 2 * el_); } } while (0)
#define P8_XN(XN_) do { const LAS f32x4* xp_ = (const LAS f32x4*)(XN_) + lane; _Pragma("unroll") for (int i_ = 0; i_ < 4; ++i_) { const f32x4 v_ = xp_[64 * i_]; xn2[2 * i_] = (f32x2_t){v_.x, v_.y}; xn2[2 * i_ + 1] = (f32x2_t){v_.z, v_.w}; } \
            __builtin_amdgcn_sched_barrier(0); } while (0)
#define P8_PROC(P_, Q_, SC_, PG_, Y_, s) do { float d_[4]; f32x2_t vh_[4][8]; \
            _Pragma("unroll") for (int q_ = 0; q_ < 4; ++q_) { const f32x32 z_ = __builtin_amdgcn_cvt_scalef32_pk32_f32_fp6((u32x6){P_[q_][0], P_[q_][1], P_[q_][2], P_[q_][3], Q_[q_][0], Q_[q_][1]}, 1.0f); \
                f32x2_t a2_ = (f32x2_t){0.f, 0.f}; \
                _Pragma("unroll") for (int i_ = 0; i_ < 8; ++i_) { a2_ += (f32x2_t){z_[2 * i_], z_[2 * i_ + 1]} * xn2[i_]; vh_[q_][i_] = (f32x2_t){z_[16 + 2 * i_], z_[17 + 2 * i_]}; } \
                d_[q_] = a2_.x + a2_.y; __builtin_amdgcn_sched_barrier(0); } \
              \
            float dsel_; { const bool o1_ = (lane & 1) != 0, o2_ = (lane & 2) != 0; \
              const float k01_ = o1_ ? d_[1] : d_[0], s01_ = o1_ ? d_[0] : d_[1], k23_ = o1_ ? d_[3] : d_[2], s23_ = o1_ ? d_[2] : d_[3]; \
              const float b_ = k01_ + DPP_F(s01_, 0xB1), c_ = k23_ + DPP_F(s23_, 0xB1); \
              const float kk_ = o2_ ? c_ : b_, ss_ = o2_ ? b_ : c_; \
              float r_ = kk_ + DPP_F(ss_, 0x4E); \
              r_ += DPP_F(r_, 0x124); r_ += DPP_F(r_, 0x128);              \
              r_ = xadd16(r_); r_ = xadd32(r_); dsel_ = r_; } \
            const float act_ = gelu_erf(dsel_ * SC_.x) * (SC_.y * PG_[(s) + (lane & 3)]);        \
            _Pragma("unroll") for (int q_ = 0; q_ < 4; ++q_) { const float a_ = __builtin_bit_cast(float, __builtin_amdgcn_readlane(__builtin_bit_cast(int, act_), q_)); const f32x2_t aa_ = (f32x2_t){a_, a_}; \
                _Pragma("unroll") for (int i_ = 0; i_ < 8; ++i_) Y_[i_] += aa_ * vh_[q_][i_]; } } while (0)
#define P8_PROCL(P_, Q_, PS_, PG_, Y_, s, NP_, NQ_, NPE_, ns, LD_) do { float d_[4]; f32x2_t vh_[4][8]; \
            if (NOCOMP) { const v4u evn_ = *(const LAS v4u*)(NPE_ + (ns)); _Pragma("unroll") for (int q_ = 0; q_ < 4; ++q_) { float t_ = __builtin_bit_cast(float, P_[q_][0] ^ Q_[q_][0]); Y_[q_].x += t_; \
                if (LD_) { const unsigned e_ = (unsigned)__builtin_amdgcn_readfirstlane((int)evn_[q_]) & EMASK; const unsigned char* r_ = UB + (size_t)e_ * 1536; NP_[q_] = *(const GAS v4u*)(r_ + lane * 16); NQ_[q_] = *(const GAS u32x2f*)(r_ + 1024 + lane * 8); } } } else { \
            const float suc_ = PS_[(s) + (lane & 3)], gvc_ = PG_[(s) + (lane & 3)];        \
            const v4u ev_ = *(const LAS v4u*)(NPE_ + (ns));        \
            _Pragma("unroll") for (int q_ = 0; q_ < 4; ++q_) { const f32x32 z_ = __builtin_amdgcn_cvt_scalef32_pk32_f32_fp6((u32x6){P_[q_][0], P_[q_][1], P_[q_][2], P_[q_][3], Q_[q_][0], Q_[q_][1]}, 1.0f); \
                f32x2_t a2_ = (f32x2_t){0.f, 0.f}, b2_ = (f32x2_t){0.f, 0.f};        \
                _Pragma("unroll") for (int i_ = 0; i_ < 4; ++i_) { a2_ += (f32x2_t){z_[4 * i_], z_[4 * i_ + 1]} * xn2[2 * i_]; b2_ += (f32x2_t){z_[4 * i_ + 2], z_[4 * i_ + 3]} * xn2[2 * i_ + 1]; } \
                _Pragma("unroll") for (int i_ = 0; i_ < 8; ++i_) vh_[q_][i_] = (f32x2_t){z_[16 + 2 * i_], z_[17 + 2 * i_]}; \
                d_[q_] = (a2_.x + b2_.x) + (a2_.y + b2_.y); __builtin_amdgcn_sched_barrier(0); \
                if (LD_) { const unsigned e_ = (unsigned)__builtin_amdgcn_readfirstlane((int)ev_[q_]) & EMASK; const GAS unsigned char* r_ = (const GAS unsigned char*)UB + (size_t)e_ * 1536; unsigned l16_ = lo16, l8_ = lo8; asm volatile("" : "+v"(l16_), "+v"(l8_));        \
                  NP_[q_] = *(const GAS v4u*)(r_ + l16_); NQ_[q_] = *(const GAS u32x2f*)(r_ + 1024 + l8_); } \
                __builtin_amdgcn_sched_barrier(0); } \
              \
            float dsel_; { const bool o1_ = (lane & 1) != 0, o2_ = (lane & 2) != 0; \
              const float k01_ = o1_ ? d_[1] : d_[0], s01_ = o1_ ? d_[0] : d_[1], k23_ = o1_ ? d_[3] : d_[2], s23_ = o1_ ? d_[2] : d_[3]; \
              const float b_ = k01_ + DPP_F(s01_, 0xB1), c_ = k23_ + DPP_F(s23_, 0xB1); \
              const float kk_ = o2_ ? c_ : b_, ss_ = o2_ ? b_ : c_; \
              float r_ = kk_ + DPP_F(ss_, 0x4E); \
              r_ += DPP_F(r_, 0x124); r_ += DPP_F(r_, 0x128);              \
              r_ = xadd16(r_); r_ = xadd32(r_); dsel_ = r_; } \
            const float act_ = gelu_erf(dsel_ * suc_) * gvc_;        \
            _Pragma("unroll") for (int q_ = 0; q_ < 4; ++q_) { const float a_ = __builtin_bit_cast(float, __builtin_amdgcn_readlane(__builtin_bit_cast(int, act_), q_)); const f32x2_t aa_ = (f32x2_t){a_, a_}; \
                if (NOCOMP != 2) { _Pragma("unroll") for (int i_ = 0; i_ < 8; ++i_) Y_[i_] += aa_ * vh_[q_][i_]; } else Y_[q_].x += aa_.x; } } } while (0)
        const unsigned lo16 = (unsigned)lane * 16u, lo8 = (unsigned)lane * 8u;
        f32x2_t xn2[8];
        P8_LOAD(pb, qb, sb, peB, 0);
#pragma unroll 1
        for (int s = 0; s < 124; s += 4) {
            const int sn = s + 4;
            P8_XN(xnA);
            P8_PROCL(pa, qa, psA, pgA, y2A, s, pa, qa, peA, sn, 1);
            if (F.G == 0x7ffffff1) asm volatile("s_nop 0");
            P8_XN(xnB);
            P8_PROCL(pb, qb, psB, pgB, y2B, s, pb, qb, peB, sn, 1);
        }
        P8_XN(xnA);
        P8_PROCL(pa, qa, psA, pgA, y2A, 124, pa, qa, peA, 124, 0);
        if (F.G == 0x7ffffff2) asm volatile("s_nop 0");
        P8_XN(xnB);
        P8_PROCL(pb, qb, psB, pgB, y2B, 124, pb, qb, peB, 124, 0);
#undef P8_PROCL
#undef P8_LOAD
#undef P8_PROC
#undef P8_XN
        { const int tn = (tA + 2 * NGW < T) ? tA + 2 * NGW : tA;
#pragma unroll
            for (int bi = 0; bi < 4; ++bi) raw4n[bi] = *(const GAS v4u*)(SC + (size_t)tn * 2048 + bi * 512 + lane * 8); }
#define P8_EPI(t_, Y_) do { f32x4 xv[4]; \
        { const GAS u32x2f* xr = (const GAS u32x2f*)(X + (size_t)(t_) * D) + lane; \
          _Pragma("unroll") for (int i = 0; i < 4; ++i) { const u32x2f b_ = xr[64 * i]; xv[i] = (f32x4){bf_lo(b_.x), bf_hi(b_.x), bf_lo(b_.y), bf_hi(b_.y)}; } } \
        float ss = 0.f; \
        _Pragma("unroll") for (int i = 0; i < 4; ++i) { xv[i].x += Y_[2 * i].x; xv[i].y += Y_[2 * i].y; xv[i].z += Y_[2 * i + 1].x; xv[i].w += Y_[2 * i + 1].y; ss += (xv[i].x * xv[i].x + xv[i].y * xv[i].y) + (xv[i].z * xv[i].z + xv[i].w * xv[i].w); } \
        ss = wave_sum_dpp(ss); \
        const float rf = rsqrtf(ss * (1.0f / D) + EPS); \
        { float* xr = XOUT + (size_t)(t_) * D + lane * 4; const float* gr = fing + lane * 4; \
          _Pragma("unroll") for (int i = 0; i < 4; ++i) { const f32x4 g4 = *(const f32x4*)(gr + 256 * i); f32x4 o; o.x = xv[i].x * rf * g4.x; o.y = xv[i].y * rf * g4.y; o.z = xv[i].z * rf * g4.z; o.w = xv[i].w * rf * g4.w; *(f32x4*)(xr + 256 * i) = o; } } } while (0)
        P8_EPI(tA, y2A);
        P8_EPI(tB, y2B);
        sweep_rev ^= 63u;
#undef P8_EPI
    }
}
#if REPEAT == 10
#define P8_BODY p8_phase<0xFFFFFFFFu, 0>(F, F.out); p8_phase<0xFFFFFFFFu, 1>(F, F.out);
#elif REPEAT == 11
#define P8_BODY p8_phase<2047u, 0>(F, F.out); p8_phase<0xFFFFFFFFu, 1>(F, F.out);
#elif REPEAT == 13
#define P8_BODY p8_phase<0u, 0>(F, F.out); p8_phase<0xFFFFFFFFu, 1>(F, F.out);
#elif REPEAT == 14
#define P8_BODY p8_phase<0xFFFFFFFFu, 0, 1>(F, F.out); p8_phase<0xFFFFFFFFu, 1>(F, F.out);
#elif REPEAT == 15
#define P8_BODY p8_phase<2047u, 0, 1>(F, F.out); p8_phase<0xFFFFFFFFu, 1>(F, F.out);
#elif REPEAT == 16
#define P8_BODY p8_phase<0xFFFFFFFFu, 0, 2>(F, F.out); p8_phase<0xFFFFFFFFu, 1>(F, F.out);

#else
#define P8_BODY p8_phase<0xFFFFFFFFu>(F, F.out);
#endif
struct Args { const float* in[22]; float* out; unsigned char* ws; int ph_lo, ph_hi, li, pad; };
constexpr int N_PHASES = 11;
__global__ void __launch_bounds__(NWAVES * 64, 2) skel_fwd(Args args) {
    extern __shared__ __attribute__((aligned(16))) unsigned char lds[];
    Frame F;
    F.lds = (LAS unsigned char*)lds;
    F.MISC = (volatile LAS unsigned*)(F.lds + MISC_OFF);
    F.tid = threadIdx.x; F.lane = F.tid & 63; F.wave = __builtin_amdgcn_readfirstlane(F.tid >> 6);
    F.G = gridDim.x; { const int bx = blockIdx.x; F.vcu = (F.G % 8 == 0) ? (bx % 8) * (F.G / 8) + bx / 8 : bx; }
    unsigned char* ws = args.ws; F.ws = ws; F.out = args.out;
    F.ctl = (gu32*)(ws + WS_CTL);
#pragma unroll
    for (int i = 0; i < 22; ++i) F.in[i] = args.in[i];
    for (int u = F.tid; u < (LDS_BYTES - LDSCTL_OFF) / 4; u += NWAVES * 64) ((LAS unsigned*)(F.lds + LDSCTL_OFF))[u] = 0u;
    __syncthreads();
    const int lo = args.ph_lo, hi = args.ph_hi;
    const bool use_bar = (hi - lo) > 1;
    XcdBarrier bar; bar.bar = (unsigned*)(F.ctl + CW_BAR) + args.li * XCD_BAR_WORDS; bar.x = 0; bar.st = nullptr;
    if (use_bar) bar = xcd_barrier_post((unsigned*)(F.ctl + CW_BAR) + args.li * XCD_BAR_WORDS, F.MISC + 8);
#define IN(k) (lo <= (k) && (k) < hi)
#define BOTH(k) (IN(k) && IN((k) + 1))
#define GRID_BAR() xcd_barrier(bar)
    bf16* XB = (bf16*)(ws + WS_XB); bf16* MIXED = (bf16*)(ws + WS_MIX); bf16* QX = MIXED;
    bf16* PROJ = (bf16*)(ws + WS_PROJ); bf16* OX = (bf16*)(ws + WS_OX); bf16* SC = (bf16*)(ws + WS_SC);
    float* ssq0 = (float*)(ws + WS_SSQ0); float* ssq1 = (float*)(ws + WS_SSQ1); float* ssq2 = (float*)(ws + WS_SSQ2);

#ifndef REPEAT
#define REPEAT -1
#endif
    if (IN(0)) { p0_prologue(F);
#if REPEAT == 0
        __syncthreads(); p0_prologue(F);
#endif
        if (BOTH(0)) GRID_BAR(); }
    if (IN(1)) {
        { pg8::Gemm g{XB, (const bf16*)(ws + WS_WIN), T, PROJ_N, D}; pg8::StaticOrder S; S.init(T, PROJ_N, F.G, (int)blockIdx.x);
          pg8::EpiRow<false> E{PROJ, PROJ_N, ssq0, 1};
          pg8::gemm_phase<pg8::EpiRow<false>, pg8::StaticOrder, true, true>(F.lds, g, S, E);
#if REPEAT == 1
          __syncthreads(); pg8::gemm_phase<pg8::EpiRow<false>, pg8::StaticOrder, true, true>(F.lds, g, S, E);
#endif
        }
        if (BOTH(1)) GRID_BAR();
    }
    if (IN(2)) { ml_passA(F);
#if REPEAT == 2
        ml_passA(F);
#endif
        if (BOTH(2)) GRID_BAR(); }
    if (IN(3)) { ml_passB(F);
#if REPEAT == 3
        ml_passB(F);
#endif
        if (BOTH(3)) GRID_BAR(); }
    if (IN(4)) {
        { pg8::Gemm g{(const bf16*)(ws + WS_MEMN), (const bf16*)(ws + WS_WKV), 2048, 2048, D}; pg8::StaticOrder S; S.init(2048, 2048, F.G, (int)blockIdx.x);
          pg8::EpiBlk E{(bf16*)(ws + WS_KVX), 8};
          pg8::gemm_phase<pg8::EpiBlk, pg8::StaticOrder, true, true>(F.lds, g, S, E); }
        ml_passC(F);
#if REPEAT == 4
        ml_passC(F);
#endif
        sb_phase(F, 0);
#if REPEAT == 21
        GRID_BAR(); sb_phase(F, 64);
#endif
        if (BOTH(4)) GRID_BAR();
    }
    if (IN(5)) {
        for (int it = F.vcu; it < 256; it += F.G) {
            const int which = it >> 7, rem = it & 127, bh = rem >> 2, q = rem & 3, b = bh >> 2, h = bh & 3;
            const bf16* KVB = (const bf16*)(ws + WS_KVX);
            const bf16* WQB = (const bf16*)(ws + WS_WQ) + (size_t)h * 262144; const bf16* WOB = (const bf16*)(ws + WS_WO) + (size_t)h * 262144;
            const bf16* Kb = KVB + (size_t)(b * 8 + h) * 65536; const bf16* Vb = KVB + (size_t)(b * 8 + 4 + h) * 65536;
            pg8::Gemm g{which ? WOB : Kb, which ? Vb : WQB, which ? 1024 : 256, which ? 256 : 1024, 256};
            pg8::OneUnit S{which ? q : 0, which ? 0 : q};
            pg8::EpiRow<false> E{which ? (bf16*)(ws + WS_M2) + (size_t)b * 1048576 + (size_t)h * 256 : (bf16*)(ws + WS_M1) + (size_t)b * 1048576 + (size_t)h * 262144, 1024, nullptr, 1};
            pg8::gemm_phase<pg8::EpiRow<false>, pg8::OneUnit, true, true>(F.lds, g, S, E);
            __syncthreads();
        }
        pg8::Gemm g{MIXED, (const bf16*)(ws + WS_WOUT), T, D, D}; pg8::StaticOrder S; S.init(T, D, F.G, (int)blockIdx.x);
        pg8::EpiRes<true> E{XB, XB, ssq1, D};
        pg8::gemm_phase<pg8::EpiRes<true>, pg8::StaticOrder, true, true>(F.lds, g, S, E);
        if (BOTH(5)) GRID_BAR();
    }
    if (IN(6)) {
        pg8::Gemm g{XB, (const bf16*)(ws + WS_M1), T, D, D, 4, (size_t)2 * 1024 * 1024}; pg8::StaticOrder S; S.init(T, D, F.G, (int)blockIdx.x);
        pg8::EpiSoftmax E{QX, D, ssq1, (LAS float*)(F.lds + 131072)};
        pg8::gemm_phase<pg8::EpiSoftmax, pg8::StaticOrder, true, true>(F.lds, g, S, E);
        if (BOTH(6)) GRID_BAR();
    }
    if (IN(8)) {
        pg8::Gemm g{QX, (const bf16*)(ws + WS_M2), T, D, D, 4, (size_t)2 * 1024 * 1024}; pg8::StaticOrder S; S.init(T, D, F.G, (int)blockIdx.x);
        pg8::EpiRes<true> E{XB, XB, ssq2, D};
        pg8::gemm_phase<pg8::EpiRes<true>, pg8::StaticOrder, true, true>(F.lds, g, S, E);
        if (BOTH(8)) GRID_BAR();
    }
    if (IN(9)) {
        pg8::Gemm g{XB, (const bf16*)(ws + WS_WPS), T, 2048, D}; pg8::StaticOrder S; S.init(T, 2048, F.G, (int)blockIdx.x);
        pg8::EpiRow<true> E{SC, 2048, ssq2, 16};
        pg8::gemm_phase<pg8::EpiRow<true>, pg8::StaticOrder, true, true>(F.lds, g, S, E);
#if REPEAT == 9
        __syncthreads(); pg8::gemm_phase<pg8::EpiRow<true>, pg8::StaticOrder, true, true>(F.lds, g, S, E);
#endif
        if (BOTH(9)) GRID_BAR();
    }
    if (IN(10)) { P8_BODY }
#undef IN
#undef BOTH
}

static void launch_phases(const Args& base, int lo, int hi, int li, int grid, hipStream_t stream) {
    Args a = base; a.ph_lo = lo; a.ph_hi = hi; a.li = li;
    hipLaunchKernelGGL(skel_fwd, dim3(grid), dim3(NWAVES * 64), LDS_BYTES, stream, a);
    const hipError_t le = hipPeekAtLastError();
    if (le != hipSuccess) fprintf(stderr, "kernel_launch: launch [%d,%d) failed: %s\n", lo, hi, hipGetErrorName(le));
}

extern "C" void kernel_launch(void* const* d_in, const int* in_sizes, int n_in, void* d_out, int out_size, void* d_ws, size_t ws_size, hipStream_t stream) {
    static int grid = 0;
    if (grid == 0) {
        if (n_in != 22 || in_sizes[0] != T * D || out_size != T * D || ws_size < WS_END) { fprintf(stderr, "kernel_launch: unexpected shapes (n_in %d, ws %zu)\n", n_in, ws_size); grid = -1; return; }
        int dev = 0, cus = 0, per_cu = 0;
        if (hipGetDevice(&dev) != hipSuccess || hipDeviceGetAttribute(&cus, hipDeviceAttributeMultiprocessorCount, dev) != hipSuccess) { grid = -1; return; }
        if (hipFuncSetAttribute((const void*)skel_fwd, hipFuncAttributeMaxDynamicSharedMemorySize, LDS_BYTES) != hipSuccess) { fprintf(stderr, "kernel_launch: hipFuncSetAttribute failed\n"); grid = -1; return; }
        if (hipOccupancyMaxActiveBlocksPerMultiprocessor(&per_cu, (const void*)skel_fwd, NWAVES * 64, LDS_BYTES) != hipSuccess || per_cu < 1) { fprintf(stderr, "kernel_launch: occupancy query says %d blocks/CU\n", per_cu); grid = -1; (void)hipGetLastError(); return; }
        grid = cus;
    }
    if (grid < 0) return;
    if (hipMemsetAsync((char*)d_ws + WS_CTL, 0, CTL_ZERO_BYTES, stream) != hipSuccess) return;
    Args a{};
    for (int i = 0; i < 22; ++i) a.in[i] = (const float*)d_in[i];
    a.out = (float*)d_out; a.ws = (unsigned char*)d_ws;
    unsigned char* ws = (unsigned char*)d_ws; float* out = (float*)d_out;
    const unsigned short* PROJ = (const unsigned short*)(ws + WS_PROJ);
    (void)out; (void)PROJ;
#if HYBRID >= 1
    for (int p = 0; p < N_PHASES; ++p) launch_phases(a, p, p + 1, 0, grid, stream);
#else
    launch_phases(a, 0, N_PHASES, 0, grid, stream);
#endif
}
```
